# Optimizing an MI355X kernel written in HIP

```python
import math
import jax, jax.numpy as jnp
from jax import lax
import numpy as np

D_MODEL = 1024
BATCH = 4
SEQ = 4096
DEPTH = 1

EPS = 1e-6
PLE_DIM = 256
GRID_W = 64
D_MIX = D_MODEL
N_HEADS = 8
N_KV_HEADS = 2
HEAD_DIM = 64
D_ATTN = N_HEADS * HEAD_DIM
D_KV = N_KV_HEADS * HEAD_DIM
Q_BLOCK = 128
ROPE_THETA = 10000.0
D_HYENA = D_MIX - D_ATTN
HYENA_HEAD = 64
HYENA_ORDER = 2
SHORT_CONV = 3
FILTER_EMB = 33
FILTER_HIDDEN = 64
FAST_DECAY_PCT = 0.3
SLOW_DECAY_PCT = 1.5
DECAY_TARGET = 1e-2
D_IN = D_ATTN + 2 * D_KV + (HYENA_ORDER + 1) * D_HYENA
N_GROUPS = 4
EXPERTS_PER_GROUP = 8
N_EXPERTS = N_GROUPS * EXPERTS_PER_GROUP
TOP_K = 2
D_EXPERT = 512
MOE_BLOCK = 128

kernel_name = "hymba_attn_hyena_hier_moe_block"


def rms_norm(x, gain):
    xf = x.astype(jnp.float32)
    y = xf * lax.rsqrt(jnp.mean(xf * xf, axis=-1, keepdims=True) + EPS)
    return (y * gain.astype(jnp.float32)).astype(x.dtype)


def group_rms(y, gain, width):
    B, S, W = y.shape
    yg = y.reshape(B, S, W // width, width)
    return rms_norm(yg, gain.reshape(W // width, width)).reshape(B, S, W)


def rope_tables_2d(S):
    rows = S // GRID_W
    r_idx, c_idx = jnp.meshgrid(jnp.arange(rows, dtype=jnp.float32),
                                jnp.arange(GRID_W, dtype=jnp.float32), indexing="ij")
    r_idx, c_idx = r_idx.reshape(S), c_idx.reshape(S)
    half = HEAD_DIM // 2
    inv = ROPE_THETA ** (-jnp.arange(0, half, 2, dtype=jnp.float32) / half)
    ang_r = r_idx[:, None] * inv[None]
    ang_c = c_idx[:, None] * inv[None]
    return jnp.cos(ang_r), jnp.sin(ang_r), jnp.cos(ang_c), jnp.sin(ang_c)


def apply_rope_2d(x, cos_r, sin_r, cos_c, sin_c):
    half = HEAD_DIM // 2
    xf = x.astype(jnp.float32)

    def rot(a, c, s):
        n = a.shape[-1] // 2
        a1, a2 = a[..., :n], a[..., n:]
        c = c[None, :, None, :]
        s = s[None, :, None, :]
        return jnp.concatenate([a1 * c - a2 * s, a2 * c + a1 * s], axis=-1)

    out = jnp.concatenate([rot(xf[..., :half], cos_r, sin_r),
                           rot(xf[..., half:], cos_c, sin_c)], axis=-1)
    return out.astype(x.dtype)


def attention_group(q, k, v, q_gain, k_gain):
    B, S, _ = q.shape
    G = N_HEADS // N_KV_HEADS
    q = rms_norm(q.reshape(B, S, N_HEADS, HEAD_DIM), q_gain)
    k = rms_norm(k.reshape(B, S, N_KV_HEADS, HEAD_DIM), k_gain)
    v = v.reshape(B, S, N_KV_HEADS, HEAD_DIM)
    cos_r, sin_r, cos_c, sin_c = rope_tables_2d(S)
    q = apply_rope_2d(q, cos_r, sin_r, cos_c, sin_c)
    k = apply_rope_2d(k, cos_r, sin_r, cos_c, sin_c)
    n_blk = S // Q_BLOCK
    qb = q.reshape(B, n_blk, Q_BLOCK, N_KV_HEADS, G, HEAD_DIM).transpose(1, 0, 3, 4, 2, 5)
    kt = k.transpose(0, 2, 1, 3)
    vt = v.transpose(0, 2, 1, 3)
    scale = HEAD_DIM ** -0.5

    def one_block(qi):
        s = jnp.einsum("bkgqd,bksd->bkgqs", qi, kt,
                       preferred_element_type=jnp.float32) * scale
        pr = jax.nn.softmax(s, axis=-1)
        return jnp.einsum("bkgqs,bksd->bkgqd", pr.astype(vt.dtype), vt)

    o = lax.map(one_block, qb)
    return o.transpose(1, 0, 4, 2, 3, 5).reshape(B, S, D_ATTN)


def filter_position_features(L):
    bands = (FILTER_EMB - 1) // 2
    t = jnp.linspace(0.0, 1.0, L, dtype=jnp.float32)[:, None]
    w = (2.0 * math.pi / L) * jnp.arange(L, dtype=jnp.float32)[:, None]
    f = jnp.linspace(1e-4, bands - 1, bands, dtype=jnp.float32)[None]
    z = f * w
    return jnp.concatenate([t, jnp.cos(z), -jnp.sin(z)], axis=-1)


def implicit_filters_freq(L, w_f1, b_f1, freq1, w_f2, b_f2, freq2, w_f3):
    z = filter_position_features(L)
    h = jnp.sin(freq1 * (z @ w_f1 + b_f1))
    h = jnp.sin(freq2 * (h @ w_f2 + b_f2))
    h = (h @ w_f3).astype(jnp.float32).reshape(L, HYENA_ORDER, 2, D_HYENA)
    max_decay = math.log(DECAY_TARGET) / FAST_DECAY_PCT
    min_decay = math.log(DECAY_TARGET) / SLOW_DECAY_PCT
    deltas = jnp.linspace(min_decay, max_decay, D_HYENA, dtype=jnp.float32)
    t = jnp.linspace(0.0, 1.0, L, dtype=jnp.float32)[:, None]
    decay = jnp.exp(-t * jnp.abs(deltas)[None])
    h = h * decay[:, None, None, :]
    h = h / (jnp.sum(jnp.abs(h), axis=0, keepdims=True) + EPS)
    hf, hb = h[:, :, 0], h[:, :, 1]
    circ = jnp.concatenate([hf[:1] + hb[:1], hf[1:], jnp.zeros_like(hf[:1]), hb[:0:-1]], axis=0)
    return jnp.fft.rfft(circ, n=2 * L, axis=0)


def long_conv(z, H, bias):
    L = z.shape[1]
    zf = z.astype(jnp.float32)
    Z = jnp.fft.rfft(zf, n=2 * L, axis=1)
    y = jnp.fft.irfft(Z * H[None], n=2 * L, axis=1)[:, :L]
    return (y + zf * bias.astype(jnp.float32)).astype(z.dtype)


def hyena_group(u, conv_w, conv_b, w_f1, b_f1, freq1, w_f2, b_f2, freq2, w_f3, filt_bias):
    L = u.shape[1]
    pad = SHORT_CONV // 2
    up = jnp.pad(u, ((0, 0), (pad, pad), (0, 0)))
    uc = conv_b + sum(up[:, j:j + L] * conv_w[j] for j in range(SHORT_CONV))
    v, x1, x2 = jnp.split(uc, HYENA_ORDER + 1, axis=-1)
    Hf = implicit_filters_freq(L, w_f1, b_f1, freq1, w_f2, b_f2, freq2, w_f3)
    z = v
    for o, gate in enumerate((x1, x2)):
        z = gate * long_conv(z, Hf[:, o], filt_bias[o])
    return z


def hierarchical_moe(h, w_group, b_group, w_router, b_router, w_gate, w_up, w_down):
    B, S, D = h.shape
    N = B * S
    hf = h.reshape(N, D)
    g_logits = (hf @ w_group).astype(jnp.float32) + b_group.astype(jnp.float32)
    g_prob = jax.nn.softmax(g_logits, axis=-1)
    g_top_p, g_sel = lax.top_k(g_prob, 1)
    e_logits = ((hf @ w_router).astype(jnp.float32) + b_router.astype(jnp.float32)
                ).reshape(N, N_GROUPS, EXPERTS_PER_GROUP)
    e_logits = jnp.take_along_axis(e_logits, g_sel[:, :, None], axis=1)[:, 0]
    e_prob = jax.nn.softmax(e_logits, axis=-1)
    top_p, top_i = lax.top_k(e_prob, TOP_K)
    top_p = top_p / jnp.sum(top_p, axis=-1, keepdims=True)
    weights = g_top_p * top_p
    expert = g_sel * EXPERTS_PER_GROUP + top_i

    T = MOE_BLOCK
    NK = N * TOP_K
    e_flat = expert.reshape(NK).astype(jnp.int32)
    w_flat = weights.reshape(NK)
    order = jnp.argsort(e_flat)
    e_sorted = e_flat[order]
    tok_sorted = (order // TOP_K).astype(jnp.int32)
    counts = jnp.bincount(e_flat, length=N_EXPERTS)
    starts = jnp.cumsum(counts) - counts
    padded = (counts + T - 1) // T * T
    pends = jnp.cumsum(padded)
    pstarts = pends - padded
    dest = pstarts[e_sorted] + jnp.arange(NK, dtype=jnp.int32) - starts[e_sorted]
    n_rows = -(-(NK + N_EXPERTS * (T - 1)) // T) * T
    n_blocks = n_rows // T
    row_tok = jnp.full((n_rows,), N, jnp.int32).at[dest].set(tok_sorted)
    row_w = jnp.zeros((n_rows,), jnp.float32).at[dest].set(w_flat[order])
    block_e = jnp.clip(jnp.searchsorted(pends, jnp.arange(n_blocks) * T, side="right"),
                       0, N_EXPERTS - 1)
    x_pad = jnp.concatenate([hf, jnp.zeros((1, D), hf.dtype)], axis=0)
    xb = x_pad[row_tok].reshape(n_blocks, T, D)

    def expert_block(args):
        xblk, e = args
        a = xblk @ w_gate[e]
        b = xblk @ w_up[e]
        return (jax.nn.silu(a) * b) @ w_down[e]

    yb = lax.map(expert_block, (xb, block_e)).reshape(n_rows, D)
    y = jax.ops.segment_sum(yb * row_w[:, None].astype(yb.dtype), row_tok, num_segments=N + 1)[:N]
    return y.reshape(B, S, D).astype(h.dtype)


def setup_inputs(seed: int = 0) -> dict:
    key = jax.random.key(seed)
    ks = iter(jax.random.split(key, 40))

    def nrm(shape, scale):
        return jax.random.normal(next(ks), shape, jnp.float32) * scale

    def gain(shape):
        return 1.0 + nrm(shape, 0.02)

    L = DEPTH
    return {
        "x": nrm((BATCH, SEQ, D_MODEL), 1.0),
        "p": nrm((DEPTH, BATCH, SEQ, PLE_DIM), 1.0),
        "g_mix": gain((L, D_MODEL)),
        "w_in": nrm((L, D_MODEL, D_IN), D_MODEL ** -0.5),
        "q_gain": gain((L, HEAD_DIM)),
        "k_gain": gain((L, HEAD_DIM)),
        "conv_w": nrm((L, SHORT_CONV, (HYENA_ORDER + 1) * D_HYENA), SHORT_CONV ** -0.5),
        "conv_b": nrm((L, (HYENA_ORDER + 1) * D_HYENA), 0.01),
        "w_f1": nrm((L, FILTER_EMB, FILTER_HIDDEN), FILTER_EMB ** -0.5),
        "b_f1": nrm((L, FILTER_HIDDEN), 0.1),
        "freq1": gain((L, FILTER_HIDDEN)),
        "w_f2": nrm((L, FILTER_HIDDEN, FILTER_HIDDEN), FILTER_HIDDEN ** -0.5),
        "b_f2": nrm((L, FILTER_HIDDEN), 0.1),
        "freq2": gain((L, FILTER_HIDDEN)),
        "w_f3": nrm((L, FILTER_HIDDEN, HYENA_ORDER * 2 * D_HYENA), FILTER_HIDDEN ** -0.5),
        "filt_bias": nrm((L, HYENA_ORDER, D_HYENA), 1.0),
        "g_attn_out": gain((L, D_ATTN)),
        "g_hyena_out": gain((L, D_HYENA)),
        "w_out": nrm((L, D_MIX, D_MODEL), D_MIX ** -0.5),
        "g_moe": gain((L, D_MODEL)),
        "w_group": nrm((L, D_MODEL, N_GROUPS), D_MODEL ** -0.5),
        "b_group": nrm((L, N_GROUPS), 0.01),
        "w_router": nrm((L, D_MODEL, N_EXPERTS), D_MODEL ** -0.5),
        "b_router": nrm((L, N_EXPERTS), 0.01),
        "w_gate": nrm((L, N_EXPERTS, D_MODEL, D_EXPERT), D_MODEL ** -0.5),
        "w_up": nrm((L, N_EXPERTS, D_MODEL, D_EXPERT), D_MODEL ** -0.5),
        "w_down": nrm((L, N_EXPERTS, D_EXPERT, D_MODEL), D_EXPERT ** -0.5),
        "g_ple": gain((L, D_MODEL)),
        "w_ple_gate": nrm((L, D_MODEL, D_MODEL), D_MODEL ** -0.5),
        "b_ple_gate": nrm((L, D_MODEL), 0.01),
        "w_ple": nrm((L, PLE_DIM, D_MODEL), PLE_DIM ** -0.5),
        "g_final": gain((D_MODEL,)),
    }


def reference(x, p, g_mix, w_in, q_gain, k_gain, conv_w, conv_b, w_f1, b_f1, freq1,
              w_f2, b_f2, freq2, w_f3, filt_bias, g_attn_out, g_hyena_out, w_out,
              g_moe, w_group, b_group, w_router, b_router, w_gate, w_up, w_down,
              g_ple, w_ple_gate, b_ple_gate, w_ple, g_final):
    for i in range(DEPTH):
        h = rms_norm(x, g_mix[i])
        proj = h @ w_in[i]
        q = proj[..., :D_ATTN]
        k = proj[..., D_ATTN:D_ATTN + D_KV]
        v = proj[..., D_ATTN + D_KV:D_ATTN + 2 * D_KV]
        u = proj[..., D_ATTN + 2 * D_KV:]
        ya = attention_group(q, k, v, q_gain[i], k_gain[i])
        yh = hyena_group(u, conv_w[i], conv_b[i], w_f1[i], b_f1[i], freq1[i],
                         w_f2[i], b_f2[i], freq2[i], w_f3[i], filt_bias[i])
        ya = group_rms(ya, g_attn_out[i], HEAD_DIM)
        yh = group_rms(yh, g_hyena_out[i], HYENA_HEAD)
        x = x + jnp.concatenate([ya, yh], axis=-1) @ w_out[i]
        x = x + hierarchical_moe(rms_norm(x, g_moe[i]), w_group[i], b_group[i],
                                 w_router[i], b_router[i], w_gate[i], w_up[i], w_down[i])
        gate = jax.nn.sigmoid(rms_norm(x, g_ple[i]) @ w_ple_gate[i] + b_ple_gate[i])
        x = x + (p[i] @ w_ple[i]) * gate
    return rms_norm(x, g_final)
```

```cpp
#include <hip/hip_runtime.h>
#include <hip/hip_bf16.h>
#include <cstdio>
#include <cstdint>
#include <cmath>
__device__ __forceinline__ int lane_id() { return (int)__builtin_amdgcn_mbcnt_hi(~0u, __builtin_amdgcn_mbcnt_lo(~0u, 0u)); }
__device__ __forceinline__ int opaque_tid(int wv) { int l; asm volatile("v_mbcnt_lo_u32_b32 %0, -1, 0\n\tv_mbcnt_hi_u32_b32 %0, -1, %0" : "=v"(l)); return wv * 64 + l; }
template <int M> __device__ __forceinline__ float lane_xor(float v) {
    if constexpr (M == 1) return __int_as_float(__builtin_amdgcn_update_dpp(0, __float_as_int(v), 0xB1, 0xF, 0xF, false));
    else if constexpr (M == 2) return __int_as_float(__builtin_amdgcn_update_dpp(0, __float_as_int(v), 0x4E, 0xF, 0xF, false));
    else if constexpr (M == 32) { auto rr = __builtin_amdgcn_permlane32_swap(__float_as_uint(v), __float_as_uint(v), false, false); return __uint_as_float((lane_id() & 32) ? rr[0] : rr[1]); }
    else return __int_as_float(__builtin_amdgcn_ds_swizzle(__float_as_int(v), (M << 10) | 0x1F));
}
__device__ __forceinline__ float wave_sum(float v) {
    v += lane_xor<1>(v); v += lane_xor<2>(v); v += lane_xor<4>(v); v += lane_xor<8>(v); v += lane_xor<16>(v);
    auto rr = __builtin_amdgcn_permlane32_swap(__float_as_uint(v), __float_as_uint(v), false, false); return __uint_as_float(rr[0]) + __uint_as_float(rr[1]);
}
namespace pg8 {
#define PG8_LAS __attribute__((address_space(3)))
typedef unsigned short bf16_t;
typedef short bf16x8 __attribute__((ext_vector_type(8)));
typedef float f32x4 __attribute__((ext_vector_type(4)));
typedef unsigned u32x4 __attribute__((ext_vector_type(4)));
constexpr int BM = 256, BK = 64, HALF = 128, HTB = HALF * BK * 2  , STAGE_BYTES = 8 * HTB;

__host__ __device__ __forceinline__ int lds_byte(int r, int c) { const int st = (r >> 4) * 2 + (c >> 5), rr = r & 15, cc = c & 31, ob = rr * 64 + cc * 2; return st * 1024 + (ob ^ (((ob >> 9) & 1) << 5)); }
__host__ __device__ __forceinline__ void stage_rc(int b, int& R, int& C) { const int st = b / 1024, sb = b % 1024, swz = sb ^ (((sb >> 9) & 1) << 5); R = (st >> 1) * 16 + swz / 64; C = (st & 1) * 32 + (swz % 64) / 2; }
__host__ __device__ __forceinline__ int perm32(int rho) { const int n = rho >> 4, i = rho & 15; return 8 * (i >> 2) + 4 * n + (i & 3); }

struct Unit { int pm, pn; };
struct Gemm { const bf16_t* A; const bf16_t* Bt; int K; };

__device__ __forceinline__ unsigned cvt_pk_bf16(float lo, float hi) { unsigned r; asm volatile("v_cvt_pk_bf16_f32 %0, %1, %2" : "=v"(r) : "v"(lo), "v"(hi)); return r; }

template <class Epi, class Sched, bool GATHER = false>
__device__ __forceinline__ void gemm_phase(PG8_LAS unsigned char* lds, const Gemm g, const Sched& S, const Epi& E, int wv) {
    const int tid = opaque_tid(wv), wid = __builtin_amdgcn_readfirstlane(tid >> 6), lane = tid & 63, wr = wid >> 2, wc = wid & 3, fr = lane & 15, fq = lane >> 4;
    const int K = g.K, nt = K / BK;
    unsigned voffA[2], voffB[2]; int RA[2], CA[2];
#pragma unroll
    for (int i = 0; i < 2; ++i) { int R, C; stage_rc(tid * 16 + i * 8192, R, C); const int Rb = (R & ~31) + perm32(R & 31);
        RA[i] = R; CA[i] = C; voffA[i] = (unsigned)(R * K + C) * 2u; voffB[i] = (unsigned)(Rb * K + C) * 2u; }
    const size_t kstep = (size_t)(BK * 2);
    const size_t hstep = (size_t)HALF * K * 2;
    const size_t tstep = 2 * hstep;
    const size_t hstepA = GATHER ? 0 : hstep, tstepA = GATHER ? 0 : tstep;
    const unsigned ldsw = (unsigned)wid * 1024u;
    const int aoff = lds_byte(wr * 64 + fr, fq * 8), boff = lds_byte(wc * 32 + fr, fq * 8);
    unsigned cvA[2][2], nvA[2][2];
#define PG8_SA(b, h) (((b) * 2 + (h)) * HTB)
#define PG8_SB(b, h) ((4 + (b) * 2 + (h)) * HTB)
#define PG8_STAGE(bufoff, gbase, voff) do { _Pragma("unroll") for (int _i = 0; _i < 2; ++_i) \
        __builtin_amdgcn_global_load_lds((const unsigned*)((const char*)(gbase) + (voff)[_i]), (PG8_LAS unsigned*)(lds + (bufoff) + ldsw + _i * 8192), 16, 0, 0); } while (0)
#define PG8_STAGE_A(bufoff, gbase, h, nx) do { if constexpr (GATHER) { unsigned _v[2]; _v[0] = (nx) ? nvA[h][0] : cvA[h][0]; _v[1] = (nx) ? nvA[h][1] : cvA[h][1]; PG8_STAGE(bufoff, gbase, _v); } \
        else { PG8_STAGE(bufoff, (gbase) + (h) * hstepA, voffA); } } while (0)
#define PG8_LDA(dst, b, h) do { _Pragma("unroll") for (int m = 0; m < 4; ++m) _Pragma("unroll") for (int k = 0; k < 2; ++k) dst[m][k] = *(const PG8_LAS bf16x8*)(lds + PG8_SA(b, h) + aoff + m * 2048 + k * 1024); } while (0)
#define PG8_LDB(dst, b, h) do { _Pragma("unroll") for (int n = 0; n < 2; ++n) _Pragma("unroll") for (int k = 0; k < 2; ++k) dst[n][k] = *(const PG8_LAS bf16x8*)(lds + PG8_SB(b, h) + boff + n * 2048 + k * 1024); } while (0)
#define PG8_MMA(ai, bj, At, Bt) do { __builtin_amdgcn_s_setprio(1); _Pragma("unroll") for (int m = 0; m < 4; ++m) _Pragma("unroll") for (int n = 0; n < 2; ++n) _Pragma("unroll") for (int k = 0; k < 2; ++k) \
        acc[ai][bj][m][n] = __builtin_amdgcn_mfma_f32_16x16x32_bf16(Bt[n][k], At[m][k], acc[ai][bj][m][n], 0, 0, 0); __builtin_amdgcn_s_setprio(0); } while (0)
#define PG8_WAIT_V(n) asm volatile("s_waitcnt vmcnt(" #n ")" ::: "memory")
#define PG8_WAIT_L(n) asm volatile("s_waitcnt lgkmcnt(" #n ")" ::: "memory")
#define PG8_BAR __builtin_amdgcn_s_barrier()
#define PG8_SCHED __builtin_amdgcn_sched_barrier(0)
#define PG8_GROWS(dst, u) do { if constexpr (GATHER) { _Pragma("unroll") for (int _h = 0; _h < 2; ++_h) _Pragma("unroll") for (int _i = 0; _i < 2; ++_i) \
        dst[_h][_i] = (unsigned)S.arow(u, _h * HALF + RA[_i]) * (unsigned)(K * 2) + (unsigned)(CA[_i] * 2); } } while (0)
    Unit cur, nxt; int ui = 0;
    if (!S.next(0, cur)) return;
    f32x4 acc[2][2][4][2];
#pragma unroll
    for (int a = 0; a < 2; ++a)
#pragma unroll
        for (int b = 0; b < 2; ++b)
#pragma unroll
            for (int m = 0; m < 4; ++m)
#pragma unroll
                for (int n = 0; n < 2; ++n) acc[a][b][m][n] = (f32x4){0.f, 0.f, 0.f, 0.f};
    bf16x8 At[4][2], B0[2][2], B1[2][2];
    const char* cA = (const char*)g.A + (size_t)cur.pm * tstepA; const char* cB = (const char*)g.Bt + (size_t)cur.pn * tstep;
    PG8_GROWS(cvA, cur);
#pragma unroll
    for (int _h = 0; _h < 2; ++_h) { nvA[_h][0] = cvA[_h][0]; nvA[_h][1] = cvA[_h][1]; }
    PG8_STAGE(PG8_SB(0, 0), cB, voffB); PG8_STAGE(PG8_SB(0, 1), cB + hstep, voffB); PG8_STAGE_A(PG8_SA(0, 0), cA, 0, false); PG8_STAGE_A(PG8_SA(0, 1), cA, 1, false);
    if (wr == 1) PG8_BAR;
    PG8_WAIT_V(2); PG8_BAR;
    PG8_STAGE(PG8_SB(1, 0), cB + kstep, voffB); PG8_STAGE_A(PG8_SA(1, 0), cA + kstep, 0, false); PG8_STAGE(PG8_SB(1, 1), cB + hstep + kstep, voffB);
    PG8_WAIT_V(6); PG8_BAR;
    for (;;) {
        const bool has_next = S.next(ui + 1, nxt);
        const char* nA = has_next ? (const char*)g.A + (size_t)nxt.pm * tstepA : cA; const char* nB = has_next ? (const char*)g.Bt + (size_t)nxt.pn * tstep : cB;
        if (has_next) PG8_GROWS(nvA, nxt);
#pragma unroll 1
        for (int t = 0; t < nt; t += 2) {
            const bool last = (t == nt - 2);
            const char* a1 = cA + (size_t)(t + 1) * kstep;
            const char* a2 = last ? nA : cA + (size_t)(t + 2) * kstep; const char* b2 = last ? nB : cB + (size_t)(t + 2) * kstep;
            const char* a3 = a2 + kstep; const char* b3 = b2 + kstep;
            PG8_LDB(B0, 0, 0); PG8_LDB(B1, 0, 1); PG8_SCHED; PG8_LDA(At, 0, 0); PG8_STAGE_A(PG8_SA(1, 1), a1, 1, false);
            PG8_WAIT_V(8); PG8_WAIT_L(0); PG8_BAR; PG8_MMA(0, 0, At, B0); PG8_MMA(0, 1, At, B1); PG8_BAR; PG8_SCHED;
            PG8_LDA(At, 0, 1); PG8_STAGE(PG8_SB(0, 0), b2, voffB); PG8_STAGE(PG8_SB(0, 1), b2 + hstep, voffB); PG8_STAGE_A(PG8_SA(0, 0), a2, 0, last);
            PG8_WAIT_V(8); PG8_WAIT_L(0); PG8_BAR; PG8_MMA(1, 0, At, B0); PG8_MMA(1, 1, At, B1); PG8_BAR; PG8_SCHED;
            PG8_LDB(B0, 1, 0); PG8_LDB(B1, 1, 1); PG8_SCHED; PG8_LDA(At, 1, 0); PG8_STAGE_A(PG8_SA(0, 1), a2, 1, last);
            PG8_WAIT_V(8); PG8_WAIT_L(0); PG8_BAR; PG8_MMA(0, 0, At, B0); PG8_MMA(0, 1, At, B1); PG8_BAR; PG8_SCHED;
            PG8_LDA(At, 1, 1); PG8_STAGE(PG8_SB(1, 0), b3, voffB); PG8_STAGE(PG8_SB(1, 1), b3 + hstep, voffB); PG8_STAGE_A(PG8_SA(1, 0), a3, 0, last);
            PG8_WAIT_V(8); PG8_WAIT_L(0); PG8_BAR; PG8_MMA(1, 0, At, B0); PG8_MMA(1, 1, At, B1); PG8_BAR; PG8_SCHED;
        }
        if (wr == 0) PG8_BAR;
        E(acc, cur, wr, wc, fr, fq);
        if (!has_next) break;
#pragma unroll
        for (int a = 0; a < 2; ++a)
#pragma unroll
            for (int b = 0; b < 2; ++b)
#pragma unroll
                for (int m = 0; m < 4; ++m)
#pragma unroll
                    for (int n = 0; n < 2; ++n) acc[a][b][m][n] = (f32x4){0.f, 0.f, 0.f, 0.f};
        cur = nxt; cA = nA; cB = nB; ++ui;
#pragma unroll
        for (int _h = 0; _h < 2; ++_h) { cvA[_h][0] = nvA[_h][0]; cvA[_h][1] = nvA[_h][1]; }
        if (wr == 1) PG8_BAR;
    }
    PG8_WAIT_V(0);
    PG8_BAR;
#undef PG8_SA
#undef PG8_SB
#undef PG8_STAGE
#undef PG8_STAGE_A
#undef PG8_LDA
#undef PG8_LDB
#undef PG8_MMA
#undef PG8_WAIT_V
#undef PG8_WAIT_L
#undef PG8_BAR
#undef PG8_SCHED
#undef PG8_GROWS
}
}
namespace attn_body {
using bf16=__hip_bfloat16;
using bf16x8=__attribute__((ext_vector_type(8)))short;
using s16x4=__attribute__((ext_vector_type(4)))short;
using f32x16=__attribute__((ext_vector_type(16)))float;
using f32x4=__attribute__((ext_vector_type(4)))float;
using u32x4=__attribute__((ext_vector_type(4)))unsigned;
constexpr int SEQ=4096,D=64,QP=512,KP=128,OP=1024,GQ=4;
constexpr int NW=8,QBLK=32,QB=QBLK*NW,KVBLK=64,NT=SEQ/KVBLK;
__device__ __forceinline__ int crow(int r,int hi){return (r&3)+8*(r>>2)+4*hi;}
#define SBAR() __builtin_amdgcn_sched_barrier(0)
constexpr int NSLOT=3, SLOTB=8192;
constexpr int LDS_K=0, LDS_V=NSLOT*SLOTB, LDS_WS=2*NSLOT*SLOTB, LDS_OST=LDS_WS+NW*64*4, LDS_BYTES=LDS_OST+NW*8192;
constexpr float C2=0.125f*1.4426950408889634f;
__device__ __forceinline__ void glds16(const void*gsrc,unsigned lds_dst){unsigned keep;
  asm volatile("s_mov_b32 %0, m0\n\ts_mov_b32 m0, %2\n\ts_nop 0\n\tglobal_load_lds_dwordx4 %1, off\n\ts_mov_b32 m0, %0":"=&s"(keep):"v"(gsrc),"s"(lds_dst):"memory");}
__device__ __forceinline__ float max3f(float a,float b,float c){float r;asm("v_max3_f32 %0, %1, %2, %3":"=v"(r):"v"(a),"v"(b),"v"(c));return r;}
__device__ __forceinline__ float max2f(float a,float b){float r;asm("v_max_f32_e32 %0, %1, %2":"=v"(r):"v"(a),"v"(b));return r;}
__device__ __forceinline__ float fadd_s(float a,float b){float r;asm("v_add_f32_e32 %0, %1, %2":"=v"(r):"v"(a),"v"(b));return r;}
__device__ __forceinline__ float fsub_s(float a,float b){float r;asm("v_sub_f32_e32 %0, %1, %2":"=v"(r):"v"(a),"v"(b));return r;}
typedef float f32x2_t __attribute__((ext_vector_type(2))); typedef __bf16 bf16x2_t __attribute__((ext_vector_type(2)));
__device__ __forceinline__ unsigned cvtpk_s(float lo,float hi){f32x2_t v={lo,hi};bf16x2_t b=__builtin_convertvector(v,bf16x2_t);return __builtin_bit_cast(unsigned,b);}
#define WAIT_BAR(N) asm volatile("s_waitcnt vmcnt(" #N ") lgkmcnt(0)\n\ts_barrier":::"memory")

__device__ __forceinline__ void qkt(f32x16&p0,f32x16&p1,const char*Kslot,const bf16x8*qr,const f32x16&negm,int r32,int hi){
  const char*kb=Kslot+hi*1024+r32*16;
  #pragma unroll
  for(int d0=0;d0<4;++d0){
    const bf16x8 b0=*reinterpret_cast<const bf16x8*>(kb+d0*2048);
    const bf16x8 b1=*reinterpret_cast<const bf16x8*>(kb+d0*2048+512);
    if(d0==0){p0=__builtin_amdgcn_mfma_f32_32x32x16_bf16(b0,qr[0],negm,0,0,0);p1=__builtin_amdgcn_mfma_f32_32x32x16_bf16(b1,qr[0],negm,0,0,0);}
    else{p0=__builtin_amdgcn_mfma_f32_32x32x16_bf16(b0,qr[d0],p0,0,0,0);p1=__builtin_amdgcn_mfma_f32_32x32x16_bf16(b1,qr[d0],p1,0,0,0);}}
}
typedef __attribute__((address_space(3))) const char* lds_cptr;
typedef short v4i16_t __attribute__((ext_vector_type(4)));
__device__ __forceinline__ void kload8(bf16x8*kf,lds_cptr kp){
  kf[0]=*(const __attribute__((address_space(3))) bf16x8*)(kp);      kf[1]=*(const __attribute__((address_space(3))) bf16x8*)(kp+512);
  kf[2]=*(const __attribute__((address_space(3))) bf16x8*)(kp+2048); kf[3]=*(const __attribute__((address_space(3))) bf16x8*)(kp+2560);
  kf[4]=*(const __attribute__((address_space(3))) bf16x8*)(kp+4096); kf[5]=*(const __attribute__((address_space(3))) bf16x8*)(kp+4608);
  kf[6]=*(const __attribute__((address_space(3))) bf16x8*)(kp+6144); kf[7]=*(const __attribute__((address_space(3))) bf16x8*)(kp+6656);
}
__device__ __forceinline__ void kload2(bf16x8*kf,lds_cptr kp,int j){ kf[2*j]=*(const __attribute__((address_space(3))) bf16x8*)(kp+j*2048); kf[2*j+1]=*(const __attribute__((address_space(3))) bf16x8*)(kp+j*2048+512); }
__device__ __forceinline__ s16x4 vtr(lds_cptr p){ return __builtin_bit_cast(s16x4,__builtin_amdgcn_ds_read_tr16_b64_v4i16((__attribute__((address_space(3))) v4i16_t*)p)); }
__device__ __forceinline__ float rowmax(const f32x16&p0,const f32x16&p1){
  float a=max3f(p0[0],p0[1],p1[0]),b=max3f(p0[2],p0[3],p1[1]);a=max3f(a,p1[2],p1[3]);
  #pragma unroll
  for(int r=4;r<16;r+=4){a=max3f(a,p0[r],p0[r+1]);b=max3f(b,p0[r+2],p0[r+3]);a=max3f(a,p1[r],p1[r+1]);b=max3f(b,p1[r+2],p1[r+3]);}
  const float m=max2f(a,b);
  auto rr=__builtin_amdgcn_permlane32_swap(__float_as_uint(m),__float_as_uint(m),false,false);
  return max2f(__uint_as_float(rr[0]),__uint_as_float(rr[1]));
}
__device__ __forceinline__ void pv(f32x16*o,int vb,bf16x8 pa0,bf16x8 pa1,bf16x8 pa2,bf16x8 pa3){
  #pragma unroll
  for(int d0=0;d0<2;++d0){s16x4 lo[4],hi[4];
    #pragma unroll
    for(int ks=0;ks<4;++ks){
      asm volatile("ds_read_b64_tr_b16 %0,%1 offset:%c2":"=&v"(lo[ks]):"v"(vb),"i"(d0*4096+ks*1024):"memory");
      asm volatile("ds_read_b64_tr_b16 %0,%1 offset:%c2":"=&v"(hi[ks]):"v"(vb),"i"(d0*4096+ks*1024+512):"memory");}
    asm volatile("s_waitcnt lgkmcnt(0)":::"memory");SBAR();
    #define PK(k) (bf16x8){lo[k][0],lo[k][1],lo[k][2],lo[k][3],hi[k][0],hi[k][1],hi[k][2],hi[k][3]}
    o[d0]=__builtin_amdgcn_mfma_f32_32x32x16_bf16(pa0,PK(0),o[d0],0,0,0);
    o[d0]=__builtin_amdgcn_mfma_f32_32x32x16_bf16(pa1,PK(1),o[d0],0,0,0);
    o[d0]=__builtin_amdgcn_mfma_f32_32x32x16_bf16(pa2,PK(2),o[d0],0,0,0);
    o[d0]=__builtin_amdgcn_mfma_f32_32x32x16_bf16(pa3,PK(3),o[d0],0,0,0);
    #undef PK
  }
}

template<int THRL> __device__ __forceinline__ void attn_unit(int b,int h,int qb,const bf16*Q,const bf16*__restrict__ K,const bf16*__restrict__ V,bf16*O,const float*__restrict__ gain,char*shm,int wv){
  const int tid=opaque_tid(wv),lane=tid&63,r32=lane&31,hi=lane>>5; const int wid=__builtin_amdgcn_readfirstlane(tid>>6);
  const long rowbase=(long)b*SEQ; const int q0=qb*QB; const int kvh=h/GQ;
  const bf16*Qw=Q+(rowbase+q0+wid*QBLK)*QP+h*D;
  const bf16*Kh=K+rowbase*KP+kvh*D,*Vh=V+rowbase*KP+kvh*D;
  const unsigned lds0=(unsigned)(uintptr_t)shm;
  float*wsf=(float*)(shm+LDS_WS)+wid*64;
  const bf16*ksrc=Kh+(long)lane*KP+wid*8;
  const bf16*vsrc=Vh+(long)(16*(wid&3)+(lane>>2))*KP+(wid>>2)*32+(lane&3)*8;
  const unsigned kdst=lds0+LDS_K+wid*1024, vdst=lds0+LDS_V+wid*1024;
  #define DMA_K(t,slot) glds16(ksrc+(long)(t)*KVBLK*KP,(unsigned)__builtin_amdgcn_readfirstlane(kdst+(slot)))
  #define DMA_V(t,slot) glds16(vsrc+(long)(t)*KVBLK*KP,(unsigned)__builtin_amdgcn_readfirstlane(vdst+(slot)))
  const int vb0=(int)(lds0+LDS_V)+((lane>>4)&1)*32+(lane&3)*8+(4*hi+((lane&15)>>2))*64;
  const char*Kbase=shm+LDS_K; bf16x8 kf[8];
  const lds_cptr shm3=(lds_cptr)shm; const lds_cptr kp0=shm3+LDS_K+hi*1024+r32*16; const lds_cptr vp0=shm3+LDS_V+((lane>>4)&1)*32+(lane&3)*8+(4*hi+((lane&15)>>2))*64;
  DMA_K(0,0);DMA_V(0,0);DMA_K(1,SLOTB);
  bf16x8 qr[4];
  #pragma unroll
  for(int d0=0;d0<4;++d0)qr[d0]=*reinterpret_cast<const bf16x8*>(&Qw[(long)r32*QP+d0*16+hi*8]);
  float mhat=0.f,l_reg=0.f;f32x16 o[2];o[0]=f32x16{};o[1]=f32x16{};f32x16 negm=f32x16{};asm volatile("":"+v"(negm));
  bool resc=false;
  #define START(P0,P1) do{ const float rm=rowmax(P0,P1); resc=false; \
    { const float dl=rm; mhat=fadd_s(mhat,dl); \
      _Pragma("unroll") for(int r=0;r<16;++r){P0[r]=fsub_s(P0[r],dl);P1[r]=fsub_s(P1[r],dl);} \
      _Pragma("unroll") for(int r=0;r<16;++r)negm[r]=-mhat; asm volatile("":"+v"(negm)); } \
    _Pragma("unroll") for(int r=0;r<16;++r)P0[r]=__builtin_amdgcn_exp2f(P0[r]); }while(0)
  #define RESC() do{ if(resc){ asm volatile("s_waitcnt lgkmcnt(0)":::"memory"); \
      _Pragma("unroll") for(int d_=0;d_<2;++d_) _Pragma("unroll") for(int r=0;r<16;++r)o[d_][r]*=wsf[crow(r,hi)]; } }while(0)
  f32x16 pA0,pA1,pB0,pB1;
  int sl_prev=0,sl_cur=0,sl_next=SLOTB;
  #define ROT() do{sl_prev=sl_cur;sl_cur=sl_next;sl_next=(sl_next==(NSLOT-1)*SLOTB)?0:sl_next+SLOTB;}while(0)
  DMA_K(2,2*SLOTB);
  WAIT_BAR(3);
  qkt(pA0,pA1,Kbase,qr,negm,r32,hi);asm volatile("s_nop 15\n\ts_nop 7":"+v"(pA0),"+v"(pA1));
  START(pA0,pA1);
  _Pragma("unroll") for(int r=0;r<16;++r)pA1[r]=__builtin_amdgcn_exp2f(pA1[r]);
  WAIT_BAR(0);
  DMA_K(3,0);DMA_V(1,SLOTB);
  ROT();
  kload8(kf,kp0+sl_cur);
  WAIT_BAR(2);
  s16x4 vlo[8],vhi[8]; u32x4 pw0,pw1,pw2,pw3;
  #define PKW(P,B) cvtpk_s(P[B],P[B+1])
  #define PAF(k) __builtin_bit_cast(bf16x8,pw##k)
  #define VFR(i) (bf16x8){vlo[i][0],vlo[i][1],vlo[i][2],vlo[i][3],vhi[i][0],vhi[i][1],vhi[i][2],vhi[i][3]}
  #define PIN(x) asm volatile("":"+v"(x))
  #define MX3(a,b,c) __builtin_fmaxf(__builtin_fmaxf((a),(b)),(c))
  #define GAPA(MF,A0,A1,A2,A3,W0,W1,PW) do{ MF; sacc+=A0; sacc+=A1; sacc+=A2; sacc+=A3; PIN(sacc); W0; W1; PIN(PW); SBAR(); }while(0)
  #define EX(v) __builtin_amdgcn_exp2f(v)
  #define GAPB(MF,X,B) do{ MF; X[B]=EX(X[B]); X[B+1]=EX(X[B+1]); X[B+2]=EX(X[B+2]); X[B+3]=EX(X[B+3]); PIN(X); SBAR(); }while(0)
  #define VRD(i) do{ vlo[i]=vtr(vp_+(((i)>>2)*4096+((i)&3)*1024)); vhi[i]=vtr(vp_+(((i)>>2)*4096+((i)&3)*1024+512)); }while(0)
  #define KRD(G,j) do{ if(G){ kload2(kf,kp0+sl_next,j); SBAR(); } }while(0)
  #define STEP(C0,C1,P0,P1,t,GK,GV,GL) do{ SBAR(); \
    const lds_cptr vp_=vp0+sl_prev; \
    VRD(0); SBAR(); float sacc=(P0[0]+P0[1]); \
    GAPA(C0=__builtin_amdgcn_mfma_f32_32x32x16_bf16(kf[0],qr[0],negm,0,0,0), P0[2],P0[3],P0[4],P0[5],     pw0[0]=PKW(P0,0), pw0[1]=PKW(P0,2), pw0); \
    VRD(4); SBAR(); GAPA(C1=__builtin_amdgcn_mfma_f32_32x32x16_bf16(kf[1],qr[0],negm,0,0,0), P0[6],P0[7],P0[8],P0[9],     pw0[2]=PKW(P0,4), pw0[3]=PKW(P0,6), pw0); \
    VRD(1); SBAR(); GAPA(C0=__builtin_amdgcn_mfma_f32_32x32x16_bf16(kf[2],qr[1],C0,0,0,0),   P0[10],P0[11],P0[12],P0[13], pw1[0]=PKW(P0,8), pw1[1]=PKW(P0,10), pw1); \
    VRD(5); SBAR(); GAPA(C1=__builtin_amdgcn_mfma_f32_32x32x16_bf16(kf[3],qr[1],C1,0,0,0),   P0[14],P0[15],P1[0],P1[1],   pw1[2]=PKW(P0,12),pw1[3]=PKW(P0,14), pw1); \
    VRD(2); SBAR(); GAPA(C0=__builtin_amdgcn_mfma_f32_32x32x16_bf16(kf[4],qr[2],C0,0,0,0),   P1[2],P1[3],P1[4],P1[5],     pw2[0]=PKW(P1,0), pw2[1]=PKW(P1,2), pw2); \
    VRD(6); SBAR(); GAPA(C1=__builtin_amdgcn_mfma_f32_32x32x16_bf16(kf[5],qr[2],C1,0,0,0),   P1[6],P1[7],P1[8],P1[9],     pw2[2]=PKW(P1,4), pw2[3]=PKW(P1,6), pw2); \
    VRD(3); SBAR(); GAPA(C0=__builtin_amdgcn_mfma_f32_32x32x16_bf16(kf[6],qr[3],C0,0,0,0),   P1[10],P1[11],P1[12],P1[13], pw3[0]=PKW(P1,8), pw3[1]=PKW(P1,10), pw3); \
    VRD(7); SBAR(); GAPA(C1=__builtin_amdgcn_mfma_f32_32x32x16_bf16(kf[7],qr[3],C1,0,0,0),   P1[14],P1[15],0.f,0.f,       pw3[2]=PKW(P1,12),pw3[3]=PKW(P1,14), pw3); \
    l_reg+=sacc; \
    if(GK){DMA_K((t)+3,sl_cur);} if(GV){DMA_V((t)+1,sl_next);} \
    { float a=MX3(C0[0],C0[1],C1[0]),b=MX3(C0[2],C0[3],C1[1]); a=MX3(a,C1[2],C1[3]); \
      _Pragma("unroll") for(int r=4;r<16;r+=4){a=MX3(a,C0[r],C0[r+1]);b=MX3(b,C0[r+2],C0[r+3]);a=MX3(a,C1[r],C1[r+1]);b=MX3(b,C1[r+2],C1[r+3]);} \
      float rm=__builtin_fmaxf(a,b); { auto rr=__builtin_amdgcn_permlane32_swap(__float_as_uint(rm),__float_as_uint(rm),false,false); rm=__builtin_fmaxf(__uint_as_float(rr[0]),__uint_as_float(rr[1])); } \
      resc=false; \
      if(__builtin_expect(__any(rm>(float)THRL),0)){ const float dl=__builtin_fmaxf(rm,0.f); mhat+=dl; \
        _Pragma("unroll") for(int r=0;r<16;++r){C0[r]-=dl;C1[r]-=dl;} \
        _Pragma("unroll") for(int r=0;r<16;++r)negm[r]=-mhat; asm volatile("":"+v"(negm)); \
        const float f=__builtin_amdgcn_exp2f(-dl); l_reg*=f; if(hi==0)wsf[r32]=f; resc=true; } } \
    SBAR(); \
    GAPB(o[0]=__builtin_amdgcn_mfma_f32_32x32x16_bf16(PAF(0),VFR(0),o[0],0,0,0), C0,0); \
    GAPB(o[1]=__builtin_amdgcn_mfma_f32_32x32x16_bf16(PAF(0),VFR(4),o[1],0,0,0), C0,4); \
    KRD(GL,0); GAPB(o[0]=__builtin_amdgcn_mfma_f32_32x32x16_bf16(PAF(1),VFR(1),o[0],0,0,0), C0,8); \
    KRD(GL,1); GAPB(o[1]=__builtin_amdgcn_mfma_f32_32x32x16_bf16(PAF(1),VFR(5),o[1],0,0,0), C0,12); \
    KRD(GL,2); GAPB(o[0]=__builtin_amdgcn_mfma_f32_32x32x16_bf16(PAF(2),VFR(2),o[0],0,0,0), C1,0); \
    KRD(GL,3); GAPB(o[1]=__builtin_amdgcn_mfma_f32_32x32x16_bf16(PAF(2),VFR(6),o[1],0,0,0), C1,4); \
    GAPB(o[0]=__builtin_amdgcn_mfma_f32_32x32x16_bf16(PAF(3),VFR(3),o[0],0,0,0), C1,8); \
    GAPB(o[1]=__builtin_amdgcn_mfma_f32_32x32x16_bf16(PAF(3),VFR(7),o[1],0,0,0), C1,12); \
    }while(0)
  int t=1;
  for(;t+5<NT;t+=2){
    STEP(pB0,pB1,pA0,pA1,t,true,true,true);     WAIT_BAR(2); RESC(); ROT();
    STEP(pA0,pA1,pB0,pB1,t+1,true,true,true);   WAIT_BAR(2); RESC(); ROT();
  }
  #define ENDW(tt) do{ if((tt)+3<NT){WAIT_BAR(2);} else if((tt)+2<NT){WAIT_BAR(1);} else {WAIT_BAR(0);} }while(0)
  for(;t+1<NT;t+=2){
    STEP(pB0,pB1,pA0,pA1,t,(t+3<NT),(t+1<NT),(t+1<NT));       ENDW(t);   RESC(); ROT();
    STEP(pA0,pA1,pB0,pB1,t+1,(t+4<NT),(t+2<NT),(t+2<NT));     ENDW(t+1); RESC(); ROT();
  }
  STEP(pB0,pB1,pA0,pA1,NT-1,false,false,false); RESC();
  { float sacc=pB0[0]+pB0[1]; _Pragma("unroll") for(int r=2;r<16;++r)sacc+=pB0[r]; _Pragma("unroll") for(int r=0;r<16;++r)sacc+=pB1[r]; l_reg+=sacc;
    pw0=(u32x4){PKW(pB0,0),PKW(pB0,2),PKW(pB0,4),PKW(pB0,6)};pw1=(u32x4){PKW(pB0,8),PKW(pB0,10),PKW(pB0,12),PKW(pB0,14)};pw2=(u32x4){PKW(pB1,0),PKW(pB1,2),PKW(pB1,4),PKW(pB1,6)};pw3=(u32x4){PKW(pB1,8),PKW(pB1,10),PKW(pB1,12),PKW(pB1,14)};
    SBAR(); pv(o,vb0+sl_cur,PAF(0),PAF(1),PAF(2),PAF(3)); }
  #undef PKW
  #undef PAF
  #undef VFR
  #undef PIN
  #undef MX3
  #undef GAPA
  #undef GAPB
  #undef EX
  #undef VRD
  #undef KRD
  #undef STEP
  #undef ENDW
  {auto rr=__builtin_amdgcn_permlane32_swap(__float_as_uint(l_reg),__float_as_uint(l_reg),false,false);l_reg=__uint_as_float(rr[0])+__uint_as_float(rr[1]);}
  if(hi==0)wsf[32+r32]=l_reg;asm volatile("s_waitcnt lgkmcnt(0)":::"memory");
  float rli[16];
  #pragma unroll
  for(int r=0;r<16;++r)rli[r]=__builtin_amdgcn_rcpf(wsf[32+crow(r,hi)]);
  bf16*Ow=O+(rowbase+q0+wid*QBLK)*OP+h*D;
  { float*stg=(float*)(shm+LDS_OST)+wid*2048;
    #pragma unroll
    for(int r=0;r<16;++r){const int orow=crow(r,hi);
      #pragma unroll
      for(int d0=0;d0<2;++d0)stg[orow*64+d0*32+r32]=o[d0][r]*rli[r];}
    asm volatile("s_waitcnt lgkmcnt(0)":::"memory");
    const int ch=lane&7; const f32x4 g0=*(const f32x4*)(gain+h*D+ch*8), g1=*(const f32x4*)(gain+h*D+ch*8+4);
    #pragma unroll
    for(int i=0;i<4;++i){const int row=i*8+(lane>>3);
      const f32x4 a=*(const f32x4*)(stg+row*64+ch*8), c=*(const f32x4*)(stg+row*64+ch*8+4);
      float ss=(a[0]*a[0]+a[1]*a[1])+(a[2]*a[2]+a[3]*a[3])+(c[0]*c[0]+c[1]*c[1])+(c[2]*c[2]+c[3]*c[3]);
      ss+=lane_xor<1>(ss); ss+=lane_xor<2>(ss); ss+=lane_xor<4>(ss);
      const float rs=__builtin_amdgcn_rsqf(ss*(1.0f/64.0f)+1e-6f);
      u32x4 v; v[0]=cvtpk_s(a[0]*rs*g0[0],a[1]*rs*g0[1]); v[1]=cvtpk_s(a[2]*rs*g0[2],a[3]*rs*g0[3]); v[2]=cvtpk_s(c[0]*rs*g1[0],c[1]*rs*g1[1]); v[3]=cvtpk_s(c[2]*rs*g1[2],c[3]*rs*g1[3]);
      *(u32x4*)(Ow+(long)row*OP+ch*8)=v;} }
  asm volatile("s_waitcnt lgkmcnt(0)\n\ts_barrier":::"memory");
  #undef DMA_K
  #undef DMA_V
  #undef START
  #undef RESC
  #undef ROT
}
#undef SBAR
#undef WAIT_BAR
}
namespace hy {
#define HY_LAS __attribute__((address_space(3)))
typedef float f2 __attribute__((ext_vector_type(2)));
typedef float f32x4 __attribute__((ext_vector_type(4)));
typedef unsigned u32x4 __attribute__((ext_vector_type(4)));
typedef HY_LAS f2* lbuf;
constexpr int N = 8192, L = 4096, NTH = 512;
constexpr int BUF_ELEMS = N + 2 * (N / 32);
constexpr int BUF_BYTES = BUF_ELEMS * 8;
constexpr int LDS_F = 0, LDS_Z = BUF_BYTES, LDS_RED = 2 * BUF_BYTES, LDS_BYTES = LDS_RED + 256;
__device__ __forceinline__ int zi(int i) { return i + ((i >> 5) << 1); }
__device__ __forceinline__ f2 cmul(f2 a, f2 b) { return (f2){a.x * b.x - a.y * b.y, a.x * b.y + a.y * b.x}; }
__device__ __forceinline__ f2 cmulc(f2 a, f2 b) { return (f2){a.x * b.x + a.y * b.y, a.y * b.x - a.x * b.y}; }
__device__ __forceinline__ f2 conjf2(f2 a) { return (f2){a.x, -a.y}; }
__device__ __forceinline__ f2 wtw(int num, int den) { float s, c; sincospif(-2.0f * (float)num / (float)den, &s, &c); return (f2){c, s}; }
__device__ __forceinline__ constexpr float c32c(int e) { constexpr float t[16] = {1.0f, 0.98078528040323043f, 0.92387953251128674f, 0.83146961230254524f, 0.70710678118654757f, 0.55557023301960229f, 0.38268343236508984f, 0.19509032201612833f,
    0.0f, -0.19509032201612819f, -0.38268343236508973f, -0.55557023301960196f, -0.70710678118654746f, -0.83146961230254535f, -0.92387953251128674f, -0.98078528040323043f}; return t[e]; }
__device__ __forceinline__ constexpr float c32s(int e) { constexpr float t[16] = {0.0f, 0.19509032201612825f, 0.38268343236508978f, 0.55557023301960218f, 0.70710678118654746f, 0.83146961230254524f, 0.92387953251128674f, 0.98078528040323043f,
    1.0f, 0.98078528040323043f, 0.92387953251128674f, 0.83146961230254546f, 0.70710678118654757f, 0.55557023301960218f, 0.38268343236508989f, 0.19509032201612861f}; return t[e]; }
#define HY_CW(e) ((f2){c32c(e), -c32s(e)})

template <int S, bool INV, bool HALFZ, bool HALFSTORE>
__device__ __forceinline__ void pass16(lbuf buf, int tid) {
    int b0, r; constexpr int QS = (S == 512) ? 544 : 34;
    if (S == 512) { b0 = tid + 2 * (tid >> 5); r = tid; } else { b0 = (tid & 31) + (tid >> 5) * 544; r = tid & 31; }
    f2 x[16];
#pragma unroll
    for (int q = 0; q < 16; ++q) { if (HALFZ && q >= 8) x[q] = (f2){0.f, 0.f}; else x[q] = buf[b0 + q * QS]; }
    const f2 w8 = wtw(r, 16 * S), w4 = cmul(w8, w8), w2 = cmul(w4, w4), w1 = cmul(w2, w2);
    if (!INV) {
#pragma unroll
        for (int hh = 0; hh < 4; ++hh) { const int h = 8 >> hh; const f2 wh = (h == 8) ? w8 : (h == 4) ? w4 : (h == 2) ? w2 : w1;
#pragma unroll
            for (int q = 0; q < 16; ++q) { if (q & h) continue;
                const f2 a = x[q], b = x[q + h]; const f2 tw = cmul(HY_CW(((q % h) * 16) / h), wh);
                x[q] = a + b; x[q + h] = cmul(a - b, tw); } }
    } else {
#pragma unroll
        for (int hh = 0; hh < 4; ++hh) { const int h = 1 << hh; const f2 wh = (h == 8) ? w8 : (h == 4) ? w4 : (h == 2) ? w2 : w1;
#pragma unroll
            for (int q = 0; q < 16; ++q) { if (q & h) continue;
                const f2 tw = cmul(HY_CW(((q % h) * 16) / h), wh); const f2 a = x[q], b = cmulc(x[q + h], tw);
                x[q] = a + b; x[q + h] = a - b; } }
    }
#pragma unroll
    for (int q = 0; q < 16; ++q) { if (HALFSTORE && q >= 8) continue; buf[b0 + q * QS] = x[q]; }
}
__device__ __forceinline__ f2 shx1(f2 v) { return (f2){lane_xor<1>(v.x), lane_xor<1>(v.y)}; }
template <bool INV>
__device__ __forceinline__ void passC(lbuf buf, int tid) {
    const int p = tid >> 1, s = tid & 1, base = 34 * p;
    if (!INV) {
        f2 lo[8], hi[8], y[16];
#pragma unroll
        for (int e = 0; e < 8; ++e) { lo[e] = buf[base + 8 * s + e]; hi[e] = buf[base + 16 + 8 * s + e]; }
#pragma unroll
        for (int e = 0; e < 8; ++e) { const f2 a = lo[e], b = hi[e]; f2 d = cmul(a - b, HY_CW(e)); if (s) d = (f2){d.y, -d.x};
            lo[e] = a + b; hi[e] = d; }
#pragma unroll
        for (int e = 0; e < 8; ++e) { const f2 send = s ? lo[e] : hi[e]; const f2 recv = shx1(send); y[e] = s ? recv : lo[e]; y[8 + e] = s ? hi[e] : recv; }
#pragma unroll
        for (int mm = 0; mm < 4; ++mm) { const int m = 8 >> mm;
#pragma unroll
            for (int e = 0; e < 16; ++e) { if (e & m) continue; const f2 a = y[e], b = y[e + m]; y[e] = a + b; y[e + m] = cmul(a - b, HY_CW(((e % m) * 16) / m)); } }
#pragma unroll
        for (int e = 0; e < 16; ++e) buf[base + 16 * s + e] = y[e];
    } else {
        f2 y[16], lo[8], hi[8];
#pragma unroll
        for (int e = 0; e < 16; ++e) y[e] = buf[base + 16 * s + e];
#pragma unroll
        for (int mm = 0; mm < 4; ++mm) { const int m = 1 << mm;
#pragma unroll
            for (int e = 0; e < 16; ++e) { if (e & m) continue; const f2 a = y[e], b = cmulc(y[e + m], HY_CW(((e % m) * 16) / m)); y[e] = a + b; y[e + m] = a - b; } }
#pragma unroll
        for (int e = 0; e < 8; ++e) { const f2 send = s ? y[e] : y[8 + e]; const f2 recv = shx1(send); lo[e] = s ? recv : y[e]; hi[e] = s ? y[8 + e] : recv; }
#pragma unroll
        for (int e = 0; e < 8; ++e) { f2 b = cmulc(hi[e], HY_CW(e)); if (s) b = (f2){-b.y, b.x};
            const f2 a = lo[e]; lo[e] = a + b; hi[e] = a - b; }
#pragma unroll
        for (int e = 0; e < 8; ++e) { buf[base + 8 * s + e] = lo[e]; buf[base + 16 + 8 * s + e] = hi[e]; }
    }
}
#define HY_SYNC() __syncthreads()
template <bool HALFZ> __device__ __forceinline__ void fft_fwd(lbuf b, int tid) { pass16<512, false, HALFZ, false>(b, tid); HY_SYNC(); pass16<32, false, false, false>(b, tid); HY_SYNC(); passC<false>(b, tid); HY_SYNC(); }
__device__ __forceinline__ void fft_inv_half(lbuf b, int tid) { passC<true>(b, tid); HY_SYNC(); pass16<32, true, false, false>(b, tid); HY_SYNC(); pass16<512, true, false, true>(b, tid); HY_SYNC(); }
__device__ __forceinline__ int brev13(int p) { return (int)(__brev((unsigned)p) >> 19); }
template <int ORDER> __device__ __forceinline__ void mulH(lbuf Z, lbuf F, int tid) {
    const int pb = 2 * tid + 2 * (tid >> 4);
#pragma unroll
    for (int j = 0; j < 8; ++j) { const int p = 2 * (tid + NTH * j); const int zp = pb + 1088 * j;
        if (p == 0) {
#pragma unroll
            for (int pp = 0; pp < 2; ++pp) { const f2 f = F[zi(pp)]; const float H = ORDER == 0 ? f.x : f.y; Z[zi(pp)] = Z[zi(pp)] * H; }
        } else {
            const int k = brev13(p), pm = brev13((N - k) & (N - 1));
            const int zm = zi(pm); const f2 f = F[zp], g = conjf2(F[zm]);
            f2 H; if (ORDER == 0) H = (f + g) * 0.5f; else { const f2 d = (f - g) * 0.5f; H = (f2){d.y, -d.x}; }
            const f2 a = Z[zp], b = Z[zm];
            Z[zp] = cmul(a, H); Z[zm] = cmulc(b, H);
        }
    }
}
__device__ __forceinline__ float bf2f(unsigned short h) { return __uint_as_float((unsigned)h << 16); }
__device__ __forceinline__ void unpack8(const u32x4 v, float* o) {
#pragma unroll
    for (int i = 0; i < 4; ++i) { o[2 * i] = __uint_as_float(v[i] << 16); o[2 * i + 1] = __uint_as_float(v[i] & 0xffff0000u); }
}
__device__ __forceinline__ unsigned pk_bf16(float lo, float hi) { typedef float f32x2_t __attribute__((ext_vector_type(2))); typedef __bf16 bf16x2_t __attribute__((ext_vector_type(2)));
    f32x2_t v = {lo, hi}; bf16x2_t b = __builtin_convertvector(v, bf16x2_t); return __builtin_bit_cast(unsigned, b); }
__device__ __forceinline__ void load_conv8(const unsigned short* urow, int b, int tid, float w0, float w1, float w2, float cb, float* o) {
    const unsigned short* p = urow + b * L + 8 * tid;
    float u[10]; unpack8(*(const u32x4*)p, u + 1);
    u[0] = tid > 0 ? bf2f(p[-1]) : 0.f; u[9] = tid < NTH - 1 ? bf2f(p[8]) : 0.f;
#pragma unroll
    for (int i = 0; i < 8; ++i) o[i] = cb + w0 * u[i] + w1 * u[i + 1] + w2 * u[i + 2];
}
__device__ __forceinline__ void hyena_unit(int c, const unsigned short* __restrict__ uT, const unsigned short* __restrict__ hraw, const float* __restrict__ conv_w, const float* __restrict__ conv_b,
                                           const float* __restrict__ filt_bias, unsigned short* yhT, HY_LAS unsigned char* lds, int wv) {
    const int tid = opaque_tid(wv), lane = tid & 63, wid = tid >> 6;
    lbuf F = (lbuf)(lds + LDS_F), Z = (lbuf)(lds + LDS_Z); HY_LAS float* red = (HY_LAS float*)(lds + LDS_RED);
    {
        float hv[4][8];
#pragma unroll
        for (int j = 0; j < 4; ++j) unpack8(*(const u32x4*)(hraw + (size_t)((j >> 1) * 1024 + (j & 1) * 512 + c) * L + 8 * tid), hv[j]);
        float s[4];
#pragma unroll
        for (int j = 0; j < 4; ++j) { float a = 0.f;
#pragma unroll
            for (int i = 0; i < 8; ++i) a += __builtin_fabsf(hv[j][i]);
            s[j] = wave_sum(a); }
        if (lane == 0) {
#pragma unroll
            for (int j = 0; j < 4; ++j) red[wid * 4 + j] = s[j]; }
        HY_SYNC();
        float sc[4];
#pragma unroll
        for (int j = 0; j < 4; ++j) { float a = 0.f;
#pragma unroll
            for (int w = 0; w < 8; ++w) a += red[w * 4 + j];
            sc[j] = (1.0f / (float)N) / (a + 1e-6f); }
        const int eb_ = 8 * tid + 2 * (tid >> 2), fb_ = N - 8 * tid + 2 * ((N - 8 * tid - 8) >> 5);
#pragma unroll
        for (int i = 0; i < 8; ++i) {
            f2 fwd = (f2){hv[0][i] * sc[0], hv[2][i] * sc[2]}; const f2 bwd = (f2){hv[1][i] * sc[1], hv[3][i] * sc[3]};
            if (i == 0) { if (tid == 0) { F[0] = fwd + bwd; F[zi(L)] = (f2){0.f, 0.f}; } else { F[eb_] = fwd; F[zi(N - 8 * tid)] = bwd; } }
            else { F[eb_ + i] = fwd; F[fb_ - i] = bwd; } }
        HY_SYNC();
        fft_fwd<false>(F, tid);
    }
    const float fb0 = filt_bias[c], fb1 = filt_bias[512 + c];
    float cw[3][3], cbv[3];
#pragma unroll
    for (int q = 0; q < 3; ++q) { cbv[q] = conv_b[q * 512 + c];
#pragma unroll
        for (int j = 0; j < 3; ++j) cw[q][j] = conv_w[j * 1536 + q * 512 + c]; }
    const int eb = 8 * tid + 2 * (tid >> 2);
    for (int pair = 0; pair < 2; ++pair) {
        const int b0 = 2 * pair, b1 = b0 + 1;
        float za[8], zb[8], ta[8], tb[8];
        load_conv8(uT + (size_t)c * 16384, b0, tid, cw[0][0], cw[0][1], cw[0][2], cbv[0], za);
        load_conv8(uT + (size_t)c * 16384, b1, tid, cw[0][0], cw[0][1], cw[0][2], cbv[0], zb);
#pragma unroll
        for (int i = 0; i < 8; ++i) Z[eb + i] = (f2){za[i], zb[i]};
        HY_SYNC();
        fft_fwd<true>(Z, tid); mulH<0>(Z, F, tid); HY_SYNC(); fft_inv_half(Z, tid);
        load_conv8(uT + (size_t)(512 + c) * 16384, b0, tid, cw[1][0], cw[1][1], cw[1][2], cbv[1], ta);
        load_conv8(uT + (size_t)(512 + c) * 16384, b1, tid, cw[1][0], cw[1][1], cw[1][2], cbv[1], tb);
#pragma unroll
        for (int i = 0; i < 8; ++i) { const f2 y = Z[eb + i]; za[i] = ta[i] * (y.x + fb0 * za[i]); zb[i] = tb[i] * (y.y + fb0 * zb[i]); }
        HY_SYNC();
#pragma unroll
        for (int i = 0; i < 8; ++i) Z[eb + i] = (f2){za[i], zb[i]};
        HY_SYNC();
        fft_fwd<true>(Z, tid); mulH<1>(Z, F, tid); HY_SYNC(); fft_inv_half(Z, tid);
        load_conv8(uT + (size_t)(1024 + c) * 16384, b0, tid, cw[2][0], cw[2][1], cw[2][2], cbv[2], ta);
        load_conv8(uT + (size_t)(1024 + c) * 16384, b1, tid, cw[2][0], cw[2][1], cw[2][2], cbv[2], tb);
#pragma unroll
        for (int i = 0; i < 8; ++i) { const f2 y = Z[eb + i]; za[i] = ta[i] * (y.x + fb1 * za[i]); zb[i] = tb[i] * (y.y + fb1 * zb[i]); }
        u32x4 oa, ob;
#pragma unroll
        for (int i = 0; i < 4; ++i) { oa[i] = pk_bf16(za[2 * i], za[2 * i + 1]); ob[i] = pk_bf16(zb[2 * i], zb[2 * i + 1]); }
        *(u32x4*)(yhT + (size_t)c * 16384 + b0 * L + 8 * tid) = oa;
        *(u32x4*)(yhT + (size_t)c * 16384 + b1 * L + 8 * tid) = ob;
        HY_SYNC();
    }
}
}
constexpr int NWAVES = 8;
#ifndef MK_N_LAUNCHES
#define MK_N_LAUNCHES 11
#endif
constexpr int PER_PHASE = 11;
constexpr int N_LAUNCHES = MK_N_LAUNCHES;

constexpr int NB_ = 4, SEQ = 4096, DM = 1024, NTOK = NB_ * SEQ;
constexpr int D_IN = 2304, D_ATTN = 512, D_KV = 128, D_HY = 512, NEXP = 32, D_EXP = 512, PLE = 256;
constexpr float EPS = 1e-6f;
constexpr int ZERO_ROW = NTOK;
constexpr int MOE_MAXROWS = 2 * NTOK + NEXP * 255;
constexpr int MOE_MAXBLK = (MOE_MAXROWS + 255) / 256;

constexpr size_t MiB = 1u << 20;
constexpr size_t WS_CTL = 0, CTL_ZERO_BYTES = 1 * MiB;
constexpr size_t WS_TAB = 1 * MiB;
constexpr size_t WS_WRT = WS_TAB + 16384;
constexpr size_t WS_HID2 = 2 * MiB;
constexpr size_t WS_WF3T = 4 * MiB;
constexpr size_t WS_WO = 5 * MiB, WS_WPG = 7 * MiB, WS_WP = 9 * MiB;
constexpr size_t WS_LIST = 10 * MiB;
constexpr size_t WS_TINFO = 12 * MiB;
constexpr size_t WS_WGU = 13 * MiB;
constexpr size_t WS_WD = 77 * MiB;
constexpr size_t WS_PB = 109 * MiB;
constexpr size_t WS_R = 117 * MiB;
constexpr size_t WS_Z = WS_R;
constexpr size_t WS_Q = WS_R + 37 * MiB, WS_K = WS_Q + 16 * MiB, WS_V = WS_K + 4 * MiB;
constexpr size_t WS_UT = WS_V + 4 * MiB;
constexpr size_t WS_HRAW = WS_UT + 48 * MiB;
constexpr size_t WS_A2 = WS_HRAW + 16 * MiB;
constexpr size_t WS_YHT = WS_R;
constexpr size_t WS_HM = WS_R;
constexpr size_t WS_ACT = WS_R + 33 * MiB;
constexpr size_t WS_YB = WS_R + 74 * MiB;
constexpr size_t WS_HM3 = WS_R;
constexpr size_t WS_PP = WS_R + 33 * MiB;
constexpr size_t WS_END = WS_A2 + 32 * MiB;
static_assert(WS_YB + (size_t)MOE_MAXBLK * 256 * 1024 * 2 <= WS_END && WS_ACT + (size_t)MOE_MAXBLK * 256 * 512 * 2 <= WS_YB && WS_HM + (size_t)(NTOK + 1) * 2048 <= WS_ACT, "ws map");
static_assert(WS_Z + (size_t)18688 * 2048 <= WS_Q, "ws map Z");
constexpr int ZR_WU = 16384, ZR_WQKV = 17920;
constexpr int CW_BAR = 4096;
constexpr int CW_CNT = 16384;

constexpr int PH_BYTES = 147456;
constexpr int MISC_OFF = PH_BYTES;
constexpr int LDS_BYTES = PH_BYTES + 4096;
constexpr int MI_BAR = 8, MI_CNT = 16, MI_BST = 48, MI_HIST = 96, MI_BASE = 128, MI_TBL = 160, MI_NB = 15;

#define GAS __attribute__((address_space(1)))
#define LAS __attribute__((address_space(3)))
typedef unsigned short bf16;
typedef unsigned v4u __attribute__((ext_vector_type(4)));
typedef unsigned v2u __attribute__((ext_vector_type(2)));
typedef float f32x4 __attribute__((ext_vector_type(4)));
typedef GAS unsigned gu32;
#define RLX_AGENT __ATOMIC_RELAXED, __HIP_MEMORY_SCOPE_AGENT
#define LDS_WAIT() asm volatile("s_waitcnt lgkmcnt(0)" ::: "memory")
__device__ __forceinline__ unsigned pk2(float lo, float hi) { return hy::pk_bf16(lo, hi); }

#define XB_TMO      128
#define XB_XCNT(j)  (256  + 64 * (j))
#define XB_XSUB(j)  (1280 + 64 * (j))
#define XB_XGEN(j)  (2304 + 64 * (j))
#define XB_TOP      3328
#define XB_TOPGEN   3392
#define XCD_BAR_WORDS 3456
#define XB_SPIN_CAP (1u << 18)
__device__ __forceinline__ unsigned xb_ld(unsigned* p)              { return __hip_atomic_load(p, __ATOMIC_RELAXED, __HIP_MEMORY_SCOPE_AGENT); }
__device__ __forceinline__ unsigned xb_add(unsigned* p, unsigned v) { return __hip_atomic_fetch_add(p, v, __ATOMIC_RELAXED, __HIP_MEMORY_SCOPE_AGENT); }
__device__ __forceinline__ unsigned xb_xcc_id() { return (unsigned)__builtin_amdgcn_s_getreg((3 << 11) | 20) & 0xFu; }
#define XB_SPIN(cond, bar) do { unsigned _sp = 0; while (cond) { __builtin_amdgcn_s_sleep(1); \
    if ((++_sp & 255u) == 0u) { if (xb_ld(&(bar)[XB_TMO])) break; if (_sp > XB_SPIN_CAP) { atomicAdd(&(bar)[XB_TMO], 1u); break; } } } } while (0)
struct XcdBarrier { unsigned* bar; unsigned x; volatile LAS unsigned* st; };
__device__ __forceinline__ XcdBarrier xcd_barrier_post(unsigned* bar, volatile LAS unsigned* st) {
    XcdBarrier b; b.bar = bar; b.x = xb_xcc_id(); b.st = st;
    if (threadIdx.x == 0) (void)xb_add(&bar[XB_XCNT(b.x)], 1u);
    return b;
}
__device__ __forceinline__ void xcd_barrier_complete(unsigned* bar, unsigned x, unsigned& nloc, unsigned& nx) {
    const unsigned G = gridDim.x * gridDim.y * gridDim.z;
    unsigned sum, cnt, mine, sp = 0u;
    for (;;) {
        sum = 0u; cnt = 0u; mine = 0u;
#pragma unroll
        for (unsigned j = 0; j < 16; ++j) { const unsigned c = xb_ld(&bar[XB_XCNT(j)]); sum += c; cnt += (c > 0u) ? 1u : 0u; mine = (j == x) ? c : mine; }
        if (sum == G) break;
        __builtin_amdgcn_s_sleep(1);
        if ((++sp & 255u) == 0u) { if (xb_ld(&bar[XB_TMO])) break; if (sp > XB_SPIN_CAP) { atomicAdd(&bar[XB_TMO], 1u); break; } }
    }
    nloc = mine > 0u ? mine : 1u; nx = cnt > 0u ? cnt : 1u;
}
__device__ __forceinline__ void xcd_barrier(const XcdBarrier& b) {
    asm volatile("s_waitcnt vmcnt(0)" ::: "memory");
    __syncthreads();
    if (threadIdx.x == 0) {
        unsigned* bar = b.bar;
        __builtin_amdgcn_s_waitcnt(0);
        unsigned nloc = b.st[0], nx = b.st[1];
        if (nloc == 0u) { xcd_barrier_complete(bar, b.x, nloc, nx); b.st[0] = nloc; b.st[1] = nx; }
        const unsigned old = xb_add(&bar[XB_XSUB(b.x)], 1u);
        const unsigned gen = old / nloc;
        if (old + 1u == (gen + 1u) * nloc) {
            __builtin_amdgcn_fence(__ATOMIC_RELEASE, "agent");
            asm volatile("s_waitcnt vmcnt(0)" ::: "memory");
            const unsigned og = xb_add(&bar[XB_TOP], 1u);
            const unsigned tg = og / nx;
            if (og + 1u == (tg + 1u) * nx) xb_add(&bar[XB_TOPGEN], 1u);
            else XB_SPIN(xb_ld(&bar[XB_TOPGEN]) == tg, bar);
            __builtin_amdgcn_fence(__ATOMIC_ACQUIRE, "agent");
            xb_add(&bar[XB_XGEN(b.x)], 1u);
            asm volatile("s_waitcnt vmcnt(0)" ::: "memory");
        } else {
            XB_SPIN(xb_ld(&bar[XB_XGEN(b.x)]) == gen, bar);
            __builtin_amdgcn_fence(__ATOMIC_ACQUIRE, "agent");
            asm volatile("s_waitcnt vmcnt(0)" ::: "memory");
        }
    }
    __syncthreads();
}


template <class RowMap>
__device__ __forceinline__ void p0_transpose_item(const float* W, int N, bf16* WT, int ldk, const RowMap& rm, LAS float* scr, int item, int lane) {
    const int nblk = N / 32, kb = item / nblk, nb = item % nblk, k0 = 64 * kb, n0 = 32 * nb;
#pragma unroll 8
    for (int i = 0; i < 32; ++i) { const int kk = 2 * i + (lane >> 5); scr[kk * 33 + (lane & 31)] = W[(size_t)(k0 + kk) * N + n0 + (lane & 31)]; }
    LDS_WAIT(); asm volatile("" ::: "memory");
    const int c = lane & 7;
#pragma unroll
    for (int j = 0; j < 4; ++j) { const int n = (lane >> 3) + 8 * j; const LAS float* s = scr + (8 * c) * 33 + n;
        v4u o; o.x = pk2(s[0 * 33], s[1 * 33]); o.y = pk2(s[2 * 33], s[3 * 33]); o.z = pk2(s[4 * 33], s[5 * 33]); o.w = pk2(s[6 * 33], s[7 * 33]);
        *(GAS v4u*)(WT + (size_t)rm(n0 + n) * ldk + k0 + 8 * c) = o; }
    LDS_WAIT(); asm volatile("" ::: "memory");
}
__host__ __device__ __forceinline__ int qk_pos(int d) { const int bj = d >> 5, dd = d & 31, nn = dd >> 4, rem = dd & 15; return 32 * bj + 8 * (rem >> 2) + 4 * nn + (rem & 3); }
struct RmIn { __device__ __forceinline__ int operator()(int n) const {
    if (n < 512) { const int hq = n >> 6, p = qk_pos(n & 63); return ZR_WQKV + 256 * (hq >> 2) + 128 * (p >> 5) + 32 * (hq & 3) + (p & 31); }
    if (n < 640) { const int hk = (n - 512) >> 6, p = qk_pos(n & 63); return ZR_WQKV + 512 + 128 * (p >> 5) + 32 * hk + (p & 31); }
    if (n < 768) { const int hv = (n - 640) >> 6, d = n & 63; return ZR_WQKV + 512 + 128 * (d >> 5) + 32 * (2 + hv) + (d & 31); }
    return ZR_WU + (n - 768); } };
struct RmNat { int off; __device__ __forceinline__ int operator()(int n) const { return off + n; } };
struct RmGU { int off; __device__ __forceinline__ int operator()(int n) const { return off + (n >> 7) * 256 + (n & 127); } };

__device__ __forceinline__ void rms_row_to_bf16(const float* xrow, const float* g, bf16* orow, int lane) {
    const GAS f32x4* xr = (const GAS f32x4*)xrow + lane; const GAS f32x4* gr = (const GAS f32x4*)g + lane;
    f32x4 v[4]; float s = 0.f;
#pragma unroll
    for (int j = 0; j < 4; ++j) { v[j] = xr[64 * j]; s += (v[j].x * v[j].x + v[j].y * v[j].y) + (v[j].z * v[j].z + v[j].w * v[j].w); }
    const float rstd = __builtin_amdgcn_rsqf(wave_sum(s) * (1.f / 1024.f) + EPS);
    GAS v2u* o8 = (GAS v2u*)orow + lane;
#pragma unroll
    for (int j = 0; j < 4; ++j) { const f32x4 gg = gr[64 * j]; v2u o; o.x = pk2(v[j].x * rstd * gg.x, v[j].y * rstd * gg.y); o.y = pk2(v[j].z * rstd * gg.z, v[j].w * rstd * gg.w); o8[64 * j] = o; }
}

using pg8::Unit; using pg8::BM; using pg8::HALF;
struct StaticOrder {
    int nM, nN, nwg, G, c;
    __device__ void init(int nM_, int nN_, int G_, int c_) { nM = nM_; nN = nN_; nwg = nM * nN; G = G_; c = c_; }
    __device__ bool next(int i, Unit& u) const {
        const long L = (long)i * G + c; if (L >= nwg) return false;
        int wgid = (int)L; { const int q = nwg / 8, r = nwg % 8, xcd = wgid % 8, off = wgid / 8; wgid = (xcd < r ? xcd * (q + 1) : r * (q + 1) + (xcd - r) * q) + off; }
        const int nig = 8 * nN, gid = wgid / nig, fm = gid * 8, gsz = (nM - fm) < 8 ? (nM - fm) : 8;
        u.pm = fm + ((wgid % nig) % gsz); u.pn = (wgid % nig) / gsz; return true;
    }
};
struct SchedP1 { int G, c;
    __device__ bool next(int i, Unit& u) const { const int L = i * G + c; if (L >= 576) return false;
        if (L < 192) { u.pm = L / 3; u.pn = 70 + L % 3; } else { const int l = L - 192; u.pm = 64 + l % 6; u.pn = l / 6; } return true; } };
struct SchedHraw { int G, c;
    __device__ bool next(int i, Unit& u) const { const int cc = (c + G - 64 % G) % G; const int L = i * G + cc; if (L >= 128) return false; u.pm = L >> 4; u.pn = L & 15; return true; } };
struct SchedMoE { int G, c; volatile LAS int* MI; const int* list;
    __device__ bool next(int i, Unit& u) const { const int L = i * G + c; const int nb = MI[MI_NB]; if (L >= nb * 4) return false;
        const int rb = L >> 2; u.pm = rb; u.pn = __builtin_amdgcn_readfirstlane(MI[MI_TBL + rb]) * 4 + (L & 3); return true; }
    __device__ __forceinline__ int arow(const Unit& u, int r) const { const int e = u.pn >> 2; const int rin = (u.pm - MI[MI_BST + e]) * 256 + r; return rin < MI[MI_CNT + e] ? list[e * NTOK + rin] : ZERO_ROW; } };
__device__ __forceinline__ void moe_tables(volatile LAS int* MI, const gu32* cnt_g, int tid) {
    __syncthreads();
    if (tid < 32) MI[MI_CNT + tid] = (int)__hip_atomic_load(cnt_g + tid, RLX_AGENT);
    __syncthreads();
    if (tid == 0) { int s = 0; for (int e = 0; e < 32; ++e) { MI[MI_BST + e] = s; const int nb = (MI[MI_CNT + e] + 255) >> 8; for (int j = 0; j < nb && s + j < MOE_MAXBLK; ++j) MI[MI_TBL + s + j] = e; s += nb; if (s > MOE_MAXBLK) s = MOE_MAXBLK; } MI[MI_BST + 32] = s; MI[MI_NB] = s; }
    __syncthreads();
}

typedef float acc_t __attribute__((ext_vector_type(4)));
#define EPI_ARGS const acc_t (&acc)[2][2][4][2], const Unit& u, int wr, int wc, int fr, int fq
struct EpiProj {
    bf16 *Q, *Kb, *Vb, *UT; const float *qg, *kg, *tab;
    __device__ __forceinline__ void operator()(EPI_ARGS) const {
        if (u.pm >= 64) {
            const int ch0 = (u.pm - 64) * BM + wr * 64 + fr, col0 = u.pn * BM + wc * 32 + 8 * fq;
#pragma unroll
            for (int ai = 0; ai < 2; ++ai)
#pragma unroll
                for (int m = 0; m < 4; ++m) { bf16* rowp = UT + (size_t)(ch0 + ai * HALF + m * 16) * NTOK + col0;
#pragma unroll
                    for (int bj = 0; bj < 2; ++bj) { const acc_t v0 = acc[ai][bj][m][0], v1 = acc[ai][bj][m][1]; v4u w; w.x = pk2(v0[0], v0[1]); w.y = pk2(v0[2], v0[3]); w.z = pk2(v1[0], v1[1]); w.w = pk2(v1[2], v1[3]);
                        *(v4u*)(rowp + bj * HALF) = w; } }
            return;
        }
        const int T = u.pn - 70, row0 = u.pm * BM + wr * 64 + fr;
        if (T == 2 && wc >= 2) {
            bf16* base = Vb + (wc - 2) * 64 + 8 * fq;
#pragma unroll
            for (int ai = 0; ai < 2; ++ai)
#pragma unroll
                for (int m = 0; m < 4; ++m) { bf16* rowp = base + (size_t)(row0 + ai * HALF + m * 16) * D_KV;
#pragma unroll
                    for (int bj = 0; bj < 2; ++bj) { const acc_t v0 = acc[ai][bj][m][0], v1 = acc[ai][bj][m][1]; v4u w; w.x = pk2(v0[0], v0[1]); w.y = pk2(v0[2], v0[3]); w.z = pk2(v1[0], v1[1]); w.w = pk2(v1[2], v1[3]);
                        *(v4u*)(rowp + bj * 32) = w; } }
            return;
        }
        const bool isq = T < 2; const float* gn = isq ? qg : kg; const float osc = isq ? attn_body::C2 : 1.0f;
        bf16* base = isq ? Q + (4 * T + wc) * 64 + 8 * fq : Kb + wc * 64 + 8 * fq; const int pitch = isq ? D_ATTN : D_KV;
        acc_t g[2][2];
#pragma unroll
        for (int bj = 0; bj < 2; ++bj)
#pragma unroll
            for (int n = 0; n < 2; ++n) g[bj][n] = *(const acc_t*)(gn + 32 * bj + 16 * n + 4 * fq);
#pragma unroll
        for (int ai = 0; ai < 2; ++ai)
#pragma unroll
            for (int m = 0; m < 4; ++m) { const int row = row0 + ai * HALF + m * 16; const int t = row & (SEQ - 1);
                float ss = 0.f;
#pragma unroll
                for (int bj = 0; bj < 2; ++bj)
#pragma unroll
                    for (int n = 0; n < 2; ++n) { const acc_t x = acc[ai][bj][m][n]; ss += (x[0] * x[0] + x[1] * x[1]) + (x[2] * x[2] + x[3] * x[3]); }
                ss += lane_xor<16>(ss); ss += lane_xor<32>(ss);
                const float rs = __builtin_amdgcn_rsqf(ss * (1.0f / 64.0f) + EPS);
#pragma unroll
                for (int bj = 0; bj < 2; ++bj) { const int idx = bj == 0 ? (t >> 6) : (t & 63);
                    const acc_t cs = *(const acc_t*)(tab + idx * 16 + 4 * fq), sn = *(const acc_t*)(tab + 1024 + idx * 16 + 4 * fq);
                    const acc_t a1 = acc[ai][bj][m][0] * rs * g[bj][0], a2 = acc[ai][bj][m][1] * rs * g[bj][1];
                    const acc_t o1 = (a1 * cs - a2 * sn) * osc, o2 = (a2 * cs + a1 * sn) * osc;
                    v4u w; w.x = pk2(o1[0], o1[1]); w.y = pk2(o1[2], o1[3]); w.z = pk2(o2[0], o2[1]); w.w = pk2(o2[2], o2[3]);
                    *(v4u*)(base + (size_t)row * pitch + bj * 32) = w; } }
    }
};
struct EpiHraw {
    bf16* H;
    __device__ __forceinline__ void operator()(EPI_ARGS) const {
        const int r0 = u.pm * BM + wr * 64 + fr, c0 = u.pn * BM + wc * 32 + 8 * fq;
        const float dmin = 4.605170185988091f / 1.5f, dmax = 4.605170185988091f / 0.3f;
#pragma unroll
        for (int ai = 0; ai < 2; ++ai)
#pragma unroll
            for (int m = 0; m < 4; ++m) { const int r = r0 + ai * HALF + m * 16; const int ch = r & 511;
                const float delta = dmin + (dmax - dmin) * ((float)ch * (1.0f / 511.0f)); const float k2 = -delta * (1.4426950408889634f / 4095.0f);
#pragma unroll
                for (int bj = 0; bj < 2; ++bj) { const int t0 = c0 + bj * HALF; float o[8];
#pragma unroll
                    for (int n = 0; n < 2; ++n)
#pragma unroll
                        for (int i = 0; i < 4; ++i) o[4 * n + i] = acc[ai][bj][m][n][i] * __builtin_amdgcn_exp2f(k2 * (float)(t0 + 4 * n + i));
                    v4u w; w.x = pk2(o[0], o[1]); w.y = pk2(o[2], o[3]); w.z = pk2(o[4], o[5]); w.w = pk2(o[6], o[7]);
                    *(v4u*)(H + (size_t)r * SEQ + t0) = w; } }
    }
};
struct EpiResid {
    const float* base; float* out;
    __device__ __forceinline__ void operator()(EPI_ARGS) const {
        const int r0 = u.pm * BM + wr * 64 + fr, c0 = u.pn * BM + wc * 32 + 8 * fq;
#pragma unroll
        for (int ai = 0; ai < 2; ++ai)
#pragma unroll
            for (int m = 0; m < 4; ++m) { const size_t off = (size_t)(r0 + ai * HALF + m * 16) * DM + c0;
#pragma unroll
                for (int bj = 0; bj < 2; ++bj)
#pragma unroll
                    for (int n = 0; n < 2; ++n) { const acc_t b = *(const acc_t*)(base + off + bj * HALF + 4 * n); *(acc_t*)(out + off + bj * HALF + 4 * n) = b + acc[ai][bj][m][n]; } }
    }
};
struct EpiSwiGLU {
    bf16* act;
    __device__ __forceinline__ void operator()(EPI_ARGS) const {
        const int r0 = u.pm * BM + wr * 64 + fr, c0 = (u.pn & 3) * 128 + wc * 32 + 8 * fq;
#pragma unroll
        for (int ai = 0; ai < 2; ++ai)
#pragma unroll
            for (int m = 0; m < 4; ++m) { float o[8];
#pragma unroll
                for (int n = 0; n < 2; ++n)
#pragma unroll
                    for (int i = 0; i < 4; ++i) { const float a = acc[ai][0][m][n][i], b = acc[ai][1][m][n][i]; o[4 * n + i] = a * b * __builtin_amdgcn_rcpf(1.0f + __builtin_amdgcn_exp2f(-1.4426950408889634f * a)); }
                v4u w; w.x = pk2(o[0], o[1]); w.y = pk2(o[2], o[3]); w.z = pk2(o[4], o[5]); w.w = pk2(o[6], o[7]);
                *(v4u*)(act + (size_t)(r0 + ai * HALF + m * 16) * D_EXP + c0) = w; }
    }
};
struct EpiBf16 {
    bf16* O; int ldc, pnmask;
    __device__ __forceinline__ void operator()(EPI_ARGS) const {
        const int r0 = u.pm * BM + wr * 64 + fr, c0 = (u.pn & pnmask) * BM + wc * 32 + 8 * fq;
#pragma unroll
        for (int ai = 0; ai < 2; ++ai)
#pragma unroll
            for (int m = 0; m < 4; ++m) { bf16* rowp = O + (size_t)(r0 + ai * HALF + m * 16) * ldc + c0;
#pragma unroll
                for (int bj = 0; bj < 2; ++bj) { const acc_t v0 = acc[ai][bj][m][0], v1 = acc[ai][bj][m][1]; v4u w; w.x = pk2(v0[0], v0[1]); w.y = pk2(v0[2], v0[3]); w.z = pk2(v1[0], v1[1]); w.w = pk2(v1[2], v1[3]);
                    *(v4u*)(rowp + bj * HALF) = w; } }
    }
};
struct EpiPle {
    float* xio; const bf16* pp; const float* bias;
    __device__ __forceinline__ void operator()(EPI_ARGS) const {
        const int r0 = u.pm * BM + wr * 64 + fr, c0 = u.pn * BM + wc * 32 + 8 * fq;
#pragma unroll
        for (int bj = 0; bj < 2; ++bj) { const acc_t bv0 = *(const acc_t*)(bias + c0 + bj * HALF), bv1 = *(const acc_t*)(bias + c0 + bj * HALF + 4);
#pragma unroll
            for (int ai = 0; ai < 2; ++ai)
#pragma unroll
                for (int m = 0; m < 4; ++m) { const size_t off = (size_t)(r0 + ai * HALF + m * 16) * DM + c0 + bj * HALF;
                    const v4u pw = *(const v4u*)(pp + off); float pv[8]; hy::unpack8(pw, pv);
                    const acc_t xa = *(const acc_t*)(xio + off), xb = *(const acc_t*)(xio + off + 4); acc_t oa, ob;
#pragma unroll
                    for (int i = 0; i < 4; ++i) { const float za = acc[ai][bj][m][0][i] + bv0[i], zb = acc[ai][bj][m][1][i] + bv1[i];
                        oa[i] = xa[i] + pv[i] * __builtin_amdgcn_rcpf(1.0f + __builtin_amdgcn_exp2f(-1.4426950408889634f * za));
                        ob[i] = xb[i] + pv[4 + i] * __builtin_amdgcn_rcpf(1.0f + __builtin_amdgcn_exp2f(-1.4426950408889634f * zb)); }
                    *(acc_t*)(xio + off) = oa; *(acc_t*)(xio + off + 4) = ob;
                    if (m & 1) asm volatile("" ::: "memory"); } }
    }
};
struct Args { const float* in[32]; float* out; unsigned char* ws; int ph_lo, ph_hi, li, pad; };
enum { I_X = 0, I_P, I_GMIX, I_WIN, I_QG, I_KG, I_CONVW, I_CONVB, I_WF1, I_BF1, I_FR1, I_WF2, I_BF2, I_FR2, I_WF3, I_FBIAS, I_GAO, I_GHO, I_WOUT, I_GMOE, I_WGRP, I_BGRP, I_WRT, I_BRT,
       I_WGATE, I_WUP, I_WDOWN, I_GPLE, I_WPG, I_BPG, I_WPLE, I_GFIN };

__device__ __forceinline__ void p0_prologue(const Args& a, LAS unsigned char* lds, int vcu, int G, int tid) {
    const int lane = tid & 63, wave = tid >> 6;
    LAS float* scr = (LAS float*)(lds + wave * 16384);
    const int gw = vcu * NWAVES + wave, NGW = G * NWAVES;
    unsigned char* ws = a.ws;
    bf16* Z = (bf16*)(ws + WS_Z);
    constexpr int I_IN = 16 * 72, I_O = 16 * 32, I_PG = 16 * 32, I_PL = 4 * 32, I_G1 = 16 * 16, I_D1 = 8 * 32, I_F3 = 64;
    constexpr int NITEMS = I_IN + I_O + I_PG + I_PL + 32 * (2 * I_G1 + I_D1) + I_F3;
    for (int it = gw; it < NITEMS; it += NGW) {
        int r = it;
        if (r < I_IN) { p0_transpose_item(a.in[I_WIN], D_IN, Z, 1024, RmIn{}, scr, r, lane); continue; } r -= I_IN;
        if (r < I_O) { p0_transpose_item(a.in[I_WOUT], 1024, (bf16*)(ws + WS_WO), 1024, RmNat{0}, scr, r, lane); continue; } r -= I_O;
        if (r < I_PG) { p0_transpose_item(a.in[I_WPG], 1024, (bf16*)(ws + WS_WPG), 1024, RmNat{0}, scr, r, lane); continue; } r -= I_PG;
        if (r < I_PL) { p0_transpose_item(a.in[I_WPLE], 1024, (bf16*)(ws + WS_WP), 256, RmNat{0}, scr, r, lane); continue; } r -= I_PL;
        if (r < 32 * I_G1) { const int e = r / I_G1; p0_transpose_item(a.in[I_WGATE] + (size_t)e * 1024 * 512, 512, (bf16*)(ws + WS_WGU), 1024, RmGU{e * 1024}, scr, r % I_G1, lane); continue; } r -= 32 * I_G1;
        if (r < 32 * I_G1) { const int e = r / I_G1; p0_transpose_item(a.in[I_WUP] + (size_t)e * 1024 * 512, 512, (bf16*)(ws + WS_WGU), 1024, RmGU{e * 1024 + 128}, scr, r % I_G1, lane); continue; } r -= 32 * I_G1;
        if (r < 32 * I_D1) { const int e = r / I_D1; p0_transpose_item(a.in[I_WDOWN] + (size_t)e * 512 * 1024, 1024, (bf16*)(ws + WS_WD), 512, RmNat{e * 1024}, scr, r % I_D1, lane); continue; } r -= 32 * I_D1;
        p0_transpose_item(a.in[I_WF3], 2048, (bf16*)(ws + WS_WF3T), 256, RmNat{0}, scr, r, lane);
    }
    for (int m = gw; m < NTOK; m += NGW) rms_row_to_bf16(a.in[I_X] + (size_t)m * DM, a.in[I_GMIX], Z + (size_t)m * DM, lane);
    { const int gt = vcu * (NWAVES * 64) + tid, NGT = G * NWAVES * 64; const f32x4* p4 = (const f32x4*)a.in[I_P]; v4u* o = (v4u*)(ws + WS_PB);
      for (int i = gt; i < NTOK * PLE / 8; i += NGT) { const f32x4 x0 = p4[2 * i], x1 = p4[2 * i + 1]; v4u w; w.x = pk2(x0.x, x0.y); w.y = pk2(x0.z, x0.w); w.z = pk2(x1.x, x1.y); w.w = pk2(x1.z, x1.w); o[i] = w; } }
    { const int gt = vcu * (NWAVES * 64) + tid, NGT = G * NWAVES * 64;
      for (int i = gt; i < (2048 + 4096) * 24; i += NGT) { const int row = i / 24, ch = i % 24; bf16* base = row < 2048 ? (bf16*)(ws + WS_WF3T) + (size_t)row * 256 : (bf16*)(ws + WS_HID2) + (size_t)(row - 2048) * 256;
          *(v4u*)(base + 64 + ch * 8) = (v4u){0u, 0u, 0u, 0u}; }
      float* tab = (float*)(ws + WS_TAB);
      for (int i = gt; i < 1024; i += NGT) { const int idx = i >> 4, j = i & 15; const float inv = exp2f(-(float)(2 * j) * (13.287712379549449f / 32.0f)); float s, c; sincosf((float)idx * inv, &s, &c); tab[i] = c; tab[1024 + i] = s; }
      float* wrt = (float*)(ws + WS_WRT);
      for (int i = gt; i < 36 * 1024; i += NGT) { const int n = i >> 10, k = i & 1023; const float w = n < 4 ? a.in[I_WGRP][k * 4 + n] : a.in[I_WRT][k * 32 + n - 4]; wrt[i] = w * a.in[I_GMOE][k]; } }
    { const float* wf1 = a.in[I_WF1]; const float* wf2 = a.in[I_WF2]; bf16* hid2 = (bf16*)(ws + WS_HID2);
      const float b1 = a.in[I_BF1][lane], f1 = a.in[I_FR1][lane], b2 = a.in[I_BF2][lane], f2v = a.in[I_FR2][lane];
      for (int t = gw; t < SEQ; t += NGW) {
          float z = 0.f;
          if (lane == 0) z = (float)t * (1.0f / 4095.0f);
          else if (lane <= 32) { const int j = (lane - 1) & 15; const float f = 1e-4f + (float)j * ((15.0f - 1e-4f) / 15.0f); const float w = (6.283185307179586f / 4096.0f) * (float)t; const float ang = f * w; z = lane <= 16 ? cosf(ang) : -sinf(ang); }
          float h1 = b1;
          for (int i = 0; i < 33; ++i) h1 += __shfl(z, i) * wf1[i * 64 + lane];
          h1 = sinf(f1 * h1);
          float h2 = b2;
          for (int i = 0; i < 64; ++i) h2 += __shfl(h1, i) * wf2[i * 64 + lane];
          h2 = sinf(f2v * h2);
          hid2[(size_t)t * 256 + lane] = (bf16)(pk2(h2, 0.f) & 0xffffu);
      } }
}

__device__ __forceinline__ void p3_hyena_norm(const Args& a, LAS unsigned char* lds, int vcu, int G, int tid) {
    const int lane = tid & 63, wave = tid >> 6; const int gw = vcu * NWAVES + wave, NGW = G * NWAVES;
    const bf16* yhT = (const bf16*)(a.ws + WS_YHT); bf16* A2 = (bf16*)(a.ws + WS_A2); const float* gho = a.in[I_GHO];
    LAS bf16* tile = (LAS bf16*)(lds + wave * 16384);
    for (int it = gw; it < 8 * 256; it += NGW) {
        const int g = it & 7, tt = it >> 3, tok0 = tt * 64; const int cs = lane >> 3, chn = lane & 7;
        float v[8][8]; float ss[8];
#pragma unroll
        for (int i = 0; i < 8; ++i) ss[i] = 0.f;
#pragma unroll
        for (int j = 0; j < 8; ++j) { const int c = 8 * j + cs; hy::unpack8(*(const v4u*)(yhT + (size_t)(g * 64 + c) * NTOK + tok0 + chn * 8), v[j]);
#pragma unroll
            for (int i = 0; i < 8; ++i) ss[i] += v[j][i] * v[j][i]; }
#pragma unroll
        for (int i = 0; i < 8; ++i) { float s = ss[i]; s += lane_xor<8>(s); s += lane_xor<16>(s); s += lane_xor<32>(s); ss[i] = __builtin_amdgcn_rsqf(s * (1.0f / 64.0f) + EPS); }
#pragma unroll
        for (int j = 0; j < 8; ++j) { const int c = 8 * j + cs; const float gg = gho[g * 64 + c];
#pragma unroll
            for (int i = 0; i < 8; ++i) tile[(chn * 8 + i) * 72 + c] = (bf16)(pk2(v[j][i] * ss[i] * gg, 0.f) & 0xffffu); }
        LDS_WAIT(); asm volatile("" ::: "memory");
#pragma unroll
        for (int j = 0; j < 8; ++j) { const int t = 8 * j + (lane >> 3), ch = lane & 7; const v4u w = *(const LAS v4u*)(tile + t * 72 + ch * 8);
            *(v4u*)(A2 + (size_t)(tok0 + t) * DM + 512 + g * 64 + ch * 8) = w; }
        LDS_WAIT(); asm volatile("" ::: "memory");
    }
}

__device__ __forceinline__ void p5_router(const Args& a, LAS unsigned char* lds, volatile LAS int* MI, int vcu, int G, int tid) {
    const int lane = tid & 63, wave = tid >> 6;
    unsigned char* ws = a.ws; const float* x1 = a.out; bf16* hm = (bf16*)(ws + WS_HM); int* list = (int*)(ws + WS_LIST); int* tinfo = (int*)(ws + WS_TINFO); gu32* cnt_g = (gu32*)(ws + WS_CTL) + CW_CNT;
    { const f32x4* src = (const f32x4*)(ws + WS_WRT); LAS f32x4* dst = (LAS f32x4*)lds; for (int i = tid; i < 36 * 256; i += NWAVES * 64) dst[i] = src[i]; }
    if (vcu == 0) { for (int i = tid; i < 256; i += NWAVES * 64) ((v2u*)(hm + (size_t)ZERO_ROW * DM))[i] = (v2u){0u, 0u}; }
    const LAS f32x4* W4 = (const LAS f32x4*)lds; const f32x4* g4 = (const f32x4*)a.in[I_GMOE];
#pragma unroll 1
    for (int tile = vcu; tile < NTOK / 32; tile += G) {
        if (tid < 32) MI[MI_HIST + tid] = 0;
        __syncthreads();
        const int tok0 = tile * 32 + wave * 4;
        f32x4 x[4][4]; float rstd[4];
#pragma unroll
        for (int i = 0; i < 4; ++i) { float s = 0.f;
#pragma unroll
            for (int j = 0; j < 4; ++j) { x[i][j] = ((const f32x4*)(x1 + (size_t)(tok0 + i) * DM))[lane + 64 * j]; s += (x[i][j].x * x[i][j].x + x[i][j].y * x[i][j].y) + (x[i][j].z * x[i][j].z + x[i][j].w * x[i][j].w); }
            rstd[i] = __builtin_amdgcn_rsqf(wave_sum(s) * (1.0f / 1024.0f) + EPS); }
        float lg[36];
#pragma unroll
        for (int n = 0; n < 36; ++n) {
            f32x4 w[4];
#pragma unroll
            for (int j = 0; j < 4; ++j) w[j] = W4[n * 256 + lane + 64 * j];
            float p[4];
#pragma unroll
            for (int i = 0; i < 4; ++i) { float s = 0.f;
#pragma unroll
                for (int j = 0; j < 4; ++j) s += (x[i][j].x * w[j].x + x[i][j].y * w[j].y) + (x[i][j].z * w[j].z + x[i][j].w * w[j].w);
                p[i] = s; }
            float q2[2], q1;
            { const bool up = lane & 32;
#pragma unroll
              for (int i = 0; i < 2; ++i) { const float keep = up ? p[2 + i] : p[i], send = up ? p[i] : p[2 + i]; q2[i] = keep + lane_xor<32>(send); } }
            { const bool up = lane & 16; const float keep = up ? q2[1] : q2[0], send = up ? q2[0] : q2[1]; q1 = keep + lane_xor<16>(send); }
            q1 += lane_xor<8>(q1); q1 += lane_xor<4>(q1); q1 += lane_xor<2>(q1); q1 += lane_xor<1>(q1);
            lg[n] = q1;
            if ((n & 3) == 3) asm volatile("" ::: "memory");
        }
#pragma unroll
        for (int i = 0; i < 4; ++i) { v2u* o8 = (v2u*)(hm + (size_t)(tok0 + i) * DM);
#pragma unroll
            for (int j = 0; j < 4; ++j) { const f32x4 gg = g4[lane + 64 * j]; const float r = rstd[i]; v2u o; o.x = pk2(x[i][j].x * r * gg.x, x[i][j].y * r * gg.y); o.y = pk2(x[i][j].z * r * gg.z, x[i][j].w * r * gg.w); o8[lane + 64 * j] = o; } }
        const int ti = lane >> 4; float myr = rstd[0];
#pragma unroll
        for (int i = 1; i < 4; ++i) myr = (ti == i) ? rstd[i] : myr;
        const float* bg = a.in[I_BGRP]; const float* br = a.in[I_BRT];
        float gl[4];
#pragma unroll
        for (int j = 0; j < 4; ++j) gl[j] = lg[j] * myr + bg[j];
        int gs = 0; float gm = gl[0];
#pragma unroll
        for (int j = 1; j < 4; ++j) if (gl[j] > gm) { gm = gl[j]; gs = j; }
        float gden = 0.f;
#pragma unroll
        for (int j = 0; j < 4; ++j) gden += __expf(gl[j] - gm);
        const float gtop = 1.0f / gden;
        float el[8];
#pragma unroll
        for (int j = 0; j < 8; ++j) { const float l0 = lg[4 + j], l1 = lg[12 + j], l2 = lg[20 + j], l3 = lg[28 + j]; const float l = gs == 0 ? l0 : gs == 1 ? l1 : gs == 2 ? l2 : l3; el[j] = l * myr + br[gs * 8 + j]; }
        int e0 = 0; float m0 = el[0];
#pragma unroll
        for (int j = 1; j < 8; ++j) if (el[j] > m0) { m0 = el[j]; e0 = j; }
        int e1 = -1; float m1 = -3.0e38f;
#pragma unroll
        for (int j = 0; j < 8; ++j) if (j != e0 && el[j] > m1) { m1 = el[j]; e1 = j; }
        const float pb = __expf(m1 - m0); const float w0 = gtop / (1.0f + pb), w1 = gtop * pb / (1.0f + pb);
        const int E0 = gs * 8 + e0, E1 = gs * 8 + e1;
        int lp0 = 0, lp1 = 0; const bool leader = (lane & 15) == 0;
        if (leader) { lp0 = __hip_atomic_fetch_add((LAS int*)(MI + MI_HIST + E0), 1, __ATOMIC_RELAXED, __HIP_MEMORY_SCOPE_WORKGROUP); lp1 = __hip_atomic_fetch_add((LAS int*)(MI + MI_HIST + E1), 1, __ATOMIC_RELAXED, __HIP_MEMORY_SCOPE_WORKGROUP); }
        __syncthreads();
        if (tid < 32) { const int h = MI[MI_HIST + tid]; MI[MI_BASE + tid] = h ? (int)__hip_atomic_fetch_add(cnt_g + tid, (unsigned)h, RLX_AGENT) : 0; }
        __syncthreads();
        if (leader) { const int tok = tok0 + ti; const int p0 = MI[MI_BASE + E0] + lp0, p1 = MI[MI_BASE + E1] + lp1;
            list[E0 * NTOK + p0] = tok; list[E1 * NTOK + p1] = tok;
            int* ti8 = tinfo + tok * 8; ti8[0] = E0; ti8[1] = p0; ti8[2] = E1; ti8[3] = p1; ti8[4] = __float_as_int(w0); ti8[5] = __float_as_int(w1); }
        __syncthreads();
    }
}

__device__ __forceinline__ void p8_combine(const Args& a, volatile LAS int* MI, int vcu, int G, int tid) {
    const int lane = tid & 63, wave = tid >> 6; const int gw = vcu * NWAVES + wave, NGW = G * NWAVES;
    float* xio = a.out; const bf16* yb = (const bf16*)(a.ws + WS_YB); bf16* hm3 = (bf16*)(a.ws + WS_HM3); const int* tinfo = (const int*)(a.ws + WS_TINFO); const f32x4* g4 = (const f32x4*)a.in[I_GPLE];
    for (int tok = gw; tok < NTOK; tok += NGW) {
        const int* ti8 = tinfo + tok * 8; const int e0 = ti8[0], p0 = ti8[1], e1 = ti8[2], p1 = ti8[3]; const float w0 = __int_as_float(ti8[4]), w1 = __int_as_float(ti8[5]);
        const size_t r0 = (size_t)MI[MI_BST + e0] * 256 + p0, r1 = (size_t)MI[MI_BST + e1] * 256 + p1;
        f32x4* xr = (f32x4*)(xio + (size_t)tok * DM); const v2u* y0 = (const v2u*)(yb + r0 * DM); const v2u* y1 = (const v2u*)(yb + r1 * DM);
        f32x4 v[4]; float s = 0.f;
#pragma unroll
        for (int j = 0; j < 4; ++j) { const f32x4 x = xr[lane + 64 * j]; const v2u a0 = y0[lane + 64 * j], a1 = y1[lane + 64 * j];
            f32x4 o; o.x = x.x + w0 * __uint_as_float(a0.x << 16) + w1 * __uint_as_float(a1.x << 16); o.y = x.y + w0 * __uint_as_float(a0.x & 0xffff0000u) + w1 * __uint_as_float(a1.x & 0xffff0000u);
            o.z = x.z + w0 * __uint_as_float(a0.y << 16) + w1 * __uint_as_float(a1.y << 16); o.w = x.w + w0 * __uint_as_float(a0.y & 0xffff0000u) + w1 * __uint_as_float(a1.y & 0xffff0000u);
            v[j] = o; s += (o.x * o.x + o.y * o.y) + (o.z * o.z + o.w * o.w); }
        const float rstd = __builtin_amdgcn_rsqf(wave_sum(s) * (1.0f / 1024.0f) + EPS);
        v2u* o8 = (v2u*)(hm3 + (size_t)tok * DM);
#pragma unroll
        for (int j = 0; j < 4; ++j) { xr[lane + 64 * j] = v[j]; const f32x4 gg = g4[lane + 64 * j]; v2u o; o.x = pk2(v[j].x * rstd * gg.x, v[j].y * rstd * gg.y); o.y = pk2(v[j].z * rstd * gg.z, v[j].w * rstd * gg.w); o8[lane + 64 * j] = o; }
    }
}
__device__ __forceinline__ void p10_final(const Args& a, int vcu, int G, int tid) {
    const int lane = tid & 63, wave = tid >> 6; const int gw = vcu * NWAVES + wave, NGW = G * NWAVES; const f32x4* g4 = (const f32x4*)a.in[I_GFIN];
    for (int tok = gw; tok < NTOK; tok += NGW) { f32x4* xr = (f32x4*)(a.out + (size_t)tok * DM); f32x4 v[4]; float s = 0.f;
#pragma unroll
        for (int j = 0; j < 4; ++j) { v[j] = xr[lane + 64 * j]; s += (v[j].x * v[j].x + v[j].y * v[j].y) + (v[j].z * v[j].z + v[j].w * v[j].w); }
        const float rstd = __builtin_amdgcn_rsqf(wave_sum(s) * (1.0f / 1024.0f) + EPS);
#pragma unroll
        for (int j = 0; j < 4; ++j) { const f32x4 gg = g4[lane + 64 * j]; xr[lane + 64 * j] = v[j] * rstd * gg; } }
}

__global__ void __launch_bounds__(NWAVES * 64, 2) mk_fwd(Args args) {
    extern __shared__ __attribute__((aligned(16))) unsigned char lds_raw[];
    LAS unsigned char* lds = (LAS unsigned char*)lds_raw;
    volatile LAS int* MI = (volatile LAS int*)(lds + MISC_OFF);
    const int tid = threadIdx.x; const int G = gridDim.x; const int bx = blockIdx.x; const int wv = __builtin_amdgcn_readfirstlane(tid >> 6);
    const int vcu = (G % 8 == 0) ? (bx % 8) * (G / 8) + bx / 8 : bx;
    unsigned char* ws = args.ws; gu32* ctl = (gu32*)(ws + WS_CTL);
    for (int u = tid; u < (LDS_BYTES - MISC_OFF) / 4; u += NWAVES * 64) MI[u] = 0;
    __syncthreads();
    XcdBarrier bar; bar.bar = (unsigned*)(ctl + CW_BAR); bar.x = 0; bar.st = nullptr;
    if (N_LAUNCHES != PER_PHASE) bar = xcd_barrier_post((unsigned*)(ctl + CW_BAR), (volatile LAS unsigned*)(MI + MI_BAR));
    const int lo = args.ph_lo, hi = args.ph_hi;
#ifndef PHMASK
#define PHMASK 0x7ff
#endif
#define IN(k) (((PHMASK >> (k)) & 1) && lo <= (k) && (k) < hi)
#define BOTH(k) (IN(k) && IN((k) + 1))
#define GRID_BAR() do { if (N_LAUNCHES != PER_PHASE) xcd_barrier(bar); } while (0)

    if (IN(0)) { p0_prologue(args, lds, vcu, G, opaque_tid(wv)); if (BOTH(0)) GRID_BAR(); }

    if (IN(1)) {
        { pg8::Gemm g{(const bf16*)(ws + WS_Z), (const bf16*)(ws + WS_Z), 1024}; SchedP1 S{G, vcu};
          EpiProj E{(bf16*)(ws + WS_Q), (bf16*)(ws + WS_K), (bf16*)(ws + WS_V), (bf16*)(ws + WS_UT), args.in[I_QG], args.in[I_KG], (const float*)(ws + WS_TAB)};
          pg8::gemm_phase<EpiProj, SchedP1, false>(lds, g, S, E, wv); }
        { pg8::Gemm g{(const bf16*)(ws + WS_WF3T), (const bf16*)(ws + WS_HID2), 256}; SchedHraw S{G, vcu}; EpiHraw E{(bf16*)(ws + WS_HRAW)};
          pg8::gemm_phase<EpiHraw, SchedHraw, false>(lds, g, S, E, wv); }
        if (BOTH(1)) GRID_BAR();
    }

    if (IN(2)) {
#ifndef NO_ATTN
        for (int au = vcu; au < 512; au += G) { const int bh = au >> 4, qb = au & 15;
            attn_body::attn_unit<8>(bh >> 3, bh & 7, qb, (const attn_body::bf16*)(ws + WS_Q), (const attn_body::bf16*)(ws + WS_K), (const attn_body::bf16*)(ws + WS_V), (attn_body::bf16*)(ws + WS_A2), args.in[I_GAO], (char*)lds_raw, wv); }
#endif
        __syncthreads();
#ifndef NO_HYENA
        for (int c = vcu; c < D_HY; c += G)
            hy::hyena_unit(c, (const bf16*)(ws + WS_UT), (const bf16*)(ws + WS_HRAW), args.in[I_CONVW], args.in[I_CONVB], args.in[I_FBIAS], (bf16*)(ws + WS_YHT), lds, wv);
#endif
        if (BOTH(2)) GRID_BAR();
    }

    if (IN(3)) { p3_hyena_norm(args, lds, vcu, G, opaque_tid(wv)); if (BOTH(3)) GRID_BAR(); }

    if (IN(4)) {
        pg8::Gemm g{(const bf16*)(ws + WS_A2), (const bf16*)(ws + WS_WO), 1024}; StaticOrder S; S.init(64, 4, G, bx); EpiResid E{args.in[I_X], args.out};
        pg8::gemm_phase<EpiResid, StaticOrder, false>(lds, g, S, E, wv);
        if (BOTH(4)) GRID_BAR();
    }

    if (IN(5)) { p5_router(args, lds, MI, vcu, G, opaque_tid(wv)); if (BOTH(5)) GRID_BAR(); }

    if (IN(6)) {
        moe_tables(MI, ctl + CW_CNT, opaque_tid(wv));
        pg8::Gemm g{(const bf16*)(ws + WS_HM), (const bf16*)(ws + WS_WGU), 1024}; SchedMoE S{G, vcu, MI, (const int*)(ws + WS_LIST)}; EpiSwiGLU E{(bf16*)(ws + WS_ACT)};
        pg8::gemm_phase<EpiSwiGLU, SchedMoE, true>(lds, g, S, E, wv);
        if (BOTH(6)) GRID_BAR();
    }

    if (IN(7)) {
        moe_tables(MI, ctl + CW_CNT, opaque_tid(wv));
        pg8::Gemm g{(const bf16*)(ws + WS_ACT), (const bf16*)(ws + WS_WD), 512}; SchedMoE S{G, vcu, MI, (const int*)(ws + WS_LIST)}; EpiBf16 E{(bf16*)(ws + WS_YB), 1024, 3};
        pg8::gemm_phase<EpiBf16, SchedMoE, false>(lds, g, S, E, wv);
        if (BOTH(7)) GRID_BAR();
    }

    if (IN(8)) { moe_tables(MI, ctl + CW_CNT, opaque_tid(wv)); p8_combine(args, MI, vcu, G, opaque_tid(wv)); if (BOTH(8)) GRID_BAR(); }

    if (IN(9)) {
#ifndef NO_P9A
        { pg8::Gemm g{(const bf16*)(ws + WS_PB), (const bf16*)(ws + WS_WP), 256}; StaticOrder S; S.init(64, 4, G, bx); EpiBf16 E{(bf16*)(ws + WS_PP), 1024, 3};
          pg8::gemm_phase<EpiBf16, StaticOrder, false>(lds, g, S, E, wv); }
#endif
        asm volatile("s_waitcnt vmcnt(0)" ::: "memory");
#ifndef NO_P9B
        { pg8::Gemm g{(const bf16*)(ws + WS_HM3), (const bf16*)(ws + WS_WPG), 1024}; StaticOrder S; S.init(64, 4, G, bx); EpiPle E{args.out, (const bf16*)(ws + WS_PP), args.in[I_BPG]};
          pg8::gemm_phase<EpiPle, StaticOrder, false>(lds, g, S, E, wv); }
#endif
        if (BOTH(9)) GRID_BAR();
    }

    if (IN(10)) { p10_final(args, vcu, G, opaque_tid(wv)); }
#undef IN
#undef BOTH
#undef GRID_BAR
}

extern "C" void kernel_launch(void* const* d_in, const int* in_sizes, int n_in, void* d_out, int out_size, void* d_ws, size_t ws_size, hipStream_t stream) {
    static int grid = 0;
    if (grid == 0) {
        if (n_in != 32 || out_size != NTOK * DM || ws_size < WS_END) { fprintf(stderr, "kernel_launch: unexpected shapes (n_in %d, out %d, ws %zu < %zu); nothing launched\n", n_in, out_size, ws_size, (size_t)WS_END); grid = -1; return; }
        int dev = 0, cus = 0, per_cu = 0;
        if (hipGetDevice(&dev) != hipSuccess || hipDeviceGetAttribute(&cus, hipDeviceAttributeMultiprocessorCount, dev) != hipSuccess) { grid = -1; return; }
        if (hipFuncSetAttribute((const void*)mk_fwd, hipFuncAttributeMaxDynamicSharedMemorySize, LDS_BYTES) != hipSuccess) { fprintf(stderr, "kernel_launch: hipFuncSetAttribute failed\n"); grid = -1; return; }
        if (hipOccupancyMaxActiveBlocksPerMultiprocessor(&per_cu, (const void*)mk_fwd, NWAVES * 64, LDS_BYTES) != hipSuccess || per_cu < 1) fprintf(stderr, "kernel_launch: occupancy query reports %d\n", per_cu);
        (void)hipGetLastError();
        grid = cus;
    }
    if (grid < 0) return;
    if (hipMemsetAsync((char*)d_ws + WS_CTL, 0, CTL_ZERO_BYTES, stream) != hipSuccess) return;
    Args a{};
    for (int i = 0; i < 32; ++i) a.in[i] = (const float*)d_in[i];
    a.out = (float*)d_out; a.ws = (unsigned char*)d_ws; a.pad = 0;
    for (int li = 0; li < N_LAUNCHES; ++li) {
        a.ph_lo = (N_LAUNCHES == PER_PHASE) ? li : 0; a.ph_hi = (N_LAUNCHES == PER_PHASE) ? li + 1 : PER_PHASE; a.li = li;
        hipLaunchKernelGGL(mk_fwd, dim3(grid), dim3(NWAVES * 64), LDS_BYTES, stream, a);
        const hipError_t le = hipPeekAtLastError();
        if (le != hipSuccess) { fprintf(stderr, "kernel_launch: launch %d failed: %s\n", li, hipGetErrorName(le)); break; }
    }
}
```
